# Optimizing an MI355X kernel written in HIP

```python
import math
import jax, jax.numpy as jnp
from jax import lax
import numpy as np

D_MODEL = 1024
BATCH = 8
SEQ = 8192
DEPTH = 2
DEC_BATCH = 32
DEC_SEQ = 2048
PAST_LEN = 128

HEAD_DIM = 64
N_HEADS = D_MODEL // HEAD_DIM
NA_HEADS = N_HEADS // 4
DIFF_HEADS = N_HEADS // 4
DIL_HEADS = N_HEADS - NA_HEADS - DIFF_HEADS
NA_WIDTH = NA_HEADS * HEAD_DIM
DIFF_WIDTH = DIFF_HEADS * HEAD_DIM
DIL_WIDTH = DIL_HEADS * HEAD_DIM
MIX_WIDTH = NA_WIDTH + DIFF_WIDTH + DIL_WIDTH
IN_WIDTH = 3 * MIX_WIDTH
GRID_W = 64
NA_WIN_ROWS = 8
NA_WIN_COLS = 16
DIFF_QK_DIM = HEAD_DIM // 2
DIFF_BLOCK = 128
DIL_PATTERNS = ((128, 1), (512, 4), (2048, 16))
FFN_HIDDEN = -(-8 * D_MODEL // (3 * 256)) * 256
ROPE_THETA = 10000.0
LN_EPS = 1e-5
DEEPNORM_ALPHA = (2 * DEPTH) ** 0.25
DEEPNORM_BETA = (8 * DEPTH) ** -0.25
NEG_INF = -1e30

kernel_name = "hybrid_natten_diff_dilated_encoder"


def layer_norm(x, g, b):
    xf = x.astype(jnp.float32)
    mu = jnp.mean(xf, axis=-1, keepdims=True)
    var = jnp.mean(jnp.square(xf - mu), axis=-1, keepdims=True)
    return ((xf - mu) * lax.rsqrt(var + LN_EPS) * g + b).astype(x.dtype)


def apply_rope(x):
    S, dim = x.shape[1], x.shape[-1]
    half = dim // 2
    inv_freq = ROPE_THETA ** (-jnp.arange(half, dtype=jnp.float32) / half)
    ang = jnp.arange(S, dtype=jnp.float32)[:, None] * inv_freq[None, :]
    shape = (S,) + (1,) * (x.ndim - 3) + (half,)
    cos = jnp.cos(ang).reshape(shape)
    sin = jnp.sin(ang).reshape(shape)
    xf = x.astype(jnp.float32)
    x1, x2 = xf[..., :half], xf[..., half:]
    return jnp.concatenate([x1 * cos - x2 * sin, x1 * sin + x2 * cos], axis=-1).astype(x.dtype)


def neighbourhood_attention(q, k, v, rpb):
    B, S, _ = q.shape
    H, dh = NA_HEADS, HEAD_DIM
    R = S // GRID_W
    wr = min(NA_WIN_ROWS, R)
    wc = NA_WIN_COLS
    q = q.reshape(B, R, GRID_W, H, dh)
    k = k.reshape(B, R, GRID_W, H, dh)
    v = v.reshape(B, R, GRID_W, H, dh)
    r_idx = jnp.arange(R)
    rows = jnp.clip(r_idx - wr // 2, 0, R - wr)[:, None] + jnp.arange(wr)[None, :]
    k_rows = k[:, rows]
    v_rows = v[:, rows]
    c_idx = jnp.arange(GRID_W)
    c_start = jnp.clip(c_idx - wc // 2, 0, GRID_W - wc)
    col_in = (c_idx[None, :] >= c_start[:, None]) & (c_idx[None, :] < c_start[:, None] + wc)
    dr = rows - r_idx[:, None] + (NA_WIN_ROWS - 1)
    dc = jnp.clip(c_idx[None, :] - c_idx[:, None] + (NA_WIN_COLS - 1), 0, 2 * NA_WIN_COLS - 2)
    bias = jnp.take(rpb[:, dr], dc, axis=-1)
    bias = bias.transpose(0, 1, 3, 2, 4).astype(jnp.float32)
    s = jnp.einsum('brchd,brjkhd->bhrcjk', q, k_rows).astype(jnp.float32) * (dh ** -0.5) + bias[None]
    s = jnp.where(col_in[:, None, :], s, NEG_INF)
    p = jax.nn.softmax(s.reshape(B, H, R, GRID_W, wr * GRID_W), axis=-1).reshape(s.shape)
    o = jnp.einsum('bhrcjk,brjkhd->brchd', p.astype(v.dtype), v_rows)
    return o.reshape(B, S, H * dh)


def differential_attention(q, k, v, lam_vecs, subln_g, lambda_init):
    B, S, _ = q.shape
    H, dq, dv = DIFF_HEADS, DIFF_QK_DIM, HEAD_DIM
    out_dtype = v.dtype
    qr = apply_rope(q.reshape(B, S, H, 2, dq)).transpose(0, 2, 3, 1, 4)
    kr = apply_rope(k.reshape(B, S, H, 2, dq)).transpose(0, 2, 3, 1, 4)
    vr = v.reshape(B, S, H, dv).transpose(0, 2, 1, 3)
    lf = lam_vecs.astype(jnp.float32)
    lam = jnp.exp(jnp.sum(lf[0] * lf[1])) - jnp.exp(jnp.sum(lf[2] * lf[3])) + lambda_init
    nb = S // DIFF_BLOCK
    q_blocks = qr.reshape(B, H, 2, nb, DIFF_BLOCK, dq).transpose(3, 0, 1, 2, 4, 5)
    scale = dq ** -0.5

    def block(qb):
        s = jnp.einsum('bhiqd,bhikd->bhiqk', qb, kr).astype(jnp.float32) * scale
        p = jax.nn.softmax(s, axis=-1)
        a = p[:, :, 0] - lam * p[:, :, 1]
        return jnp.einsum('bhqk,bhkd->bhqd', a.astype(vr.dtype), vr)

    o = lax.map(block, q_blocks)
    o = o.transpose(1, 0, 3, 2, 4).reshape(B, S, H, dv).astype(jnp.float32)
    o = o * lax.rsqrt(jnp.mean(o * o, axis=-1, keepdims=True) + LN_EPS) * subln_g * (1.0 - lambda_init)
    return o.astype(out_dtype).reshape(B, S, H * dv)


def banded_window_attention(q, k, v, half_width):
    lead = q.shape[:-2]
    L, dh = q.shape[-2], q.shape[-1]
    hw = half_width
    nb = -(-L // hw)
    Lp = nb * hw
    pad = [(0, 0)] * len(lead)
    qp = jnp.pad(q, pad + [(0, Lp - L), (0, 0)]).reshape(*lead, nb, hw, dh)
    kp = jnp.pad(k, pad + [(hw, Lp - L + hw), (0, 0)])
    vp = jnp.pad(v, pad + [(hw, Lp - L + hw), (0, 0)])

    def neighbour_blocks(a):
        return jnp.concatenate([a[..., j * hw:j * hw + Lp, :].reshape(*lead, nb, hw, dh) for j in range(3)], axis=-2)

    kb = neighbour_blocks(kp)
    vb = neighbour_blocks(vp)
    qpos = jnp.arange(Lp).reshape(nb, hw)
    kpos = jnp.arange(nb)[:, None] * hw - hw + jnp.arange(3 * hw)[None, :]
    mask = (jnp.abs(qpos[:, :, None] - kpos[:, None, :]) <= hw) & ((kpos >= 0) & (kpos < L))[:, None, :]
    s = jnp.einsum('...nqd,...nkd->...nqk', qp, kb).astype(jnp.float32) * (dh ** -0.5)
    s = jnp.where(mask, s, NEG_INF)
    m = jnp.max(s, axis=-1)
    p = jnp.exp(s - m[..., None])
    l = jnp.sum(p, axis=-1)
    o = jnp.einsum('...nqk,...nkd->...nqd', p.astype(v.dtype), vb).astype(jnp.float32)
    return (o.reshape(*lead, Lp, dh)[..., :L, :], m.reshape(*lead, Lp)[..., :L], l.reshape(*lead, Lp)[..., :L])


def to_streams(a, dilation):
    B, S, H, dh = a.shape
    return a.reshape(B, S // dilation, dilation, H, dh).transpose(0, 2, 3, 1, 4)


def dilated_attention(q, k, v):
    B, S, _ = q.shape
    H, dh = DIL_HEADS, HEAD_DIM
    out_dtype = v.dtype
    qr = apply_rope(q.reshape(B, S, H, dh))
    kr = apply_rope(k.reshape(B, S, H, dh))
    vr = v.reshape(B, S, H, dh)
    outs, maxes, dens = [], [], []
    for window, dilation in DIL_PATTERNS:
        o, m, l = banded_window_attention(to_streams(qr, dilation), to_streams(kr, dilation),
                                          to_streams(vr, dilation), window // (2 * dilation))
        outs.append(o.transpose(0, 3, 1, 2, 4).reshape(B, S, H, dh))
        maxes.append(m.transpose(0, 3, 1, 2).reshape(B, S, H))
        dens.append(l.transpose(0, 3, 1, 2).reshape(B, S, H))
    m_all = jnp.max(jnp.stack(maxes, axis=0), axis=0)
    wts = [jnp.exp(m - m_all) for m in maxes]
    num = sum(w[..., None] * o for w, o in zip(wts, outs))
    den = sum(w * l for w, l in zip(wts, dens))
    return (num / den[..., None]).astype(out_dtype).reshape(B, S, H * dh)


def encoder_trunk(x, c, w_ada, b_ada, w_in, na_rpb, diff_lambda, diff_subln_g, w_out,
                  ln1_g, ln1_b, w_gu, w_down, ln2_g, ln2_b):
    splits = [NA_WIDTH, 2 * NA_WIDTH, 3 * NA_WIDTH,
              3 * NA_WIDTH + DIFF_WIDTH, 3 * NA_WIDTH + 2 * DIFF_WIDTH, 3 * NA_WIDTH + 3 * DIFF_WIDTH,
              3 * NA_WIDTH + 3 * DIFF_WIDTH + DIL_WIDTH, 3 * NA_WIDTH + 3 * DIFF_WIDTH + 2 * DIL_WIDTH]
    for layer in range(DEPTH):
        lambda_init = 0.8 - 0.6 * math.exp(-0.3 * layer)
        mod = jax.nn.silu(c) @ w_ada[layer] + b_ada[layer]
        sh1, sc1, g1, sh2, sc2, g2 = [m[:, None, :] for m in jnp.split(mod, 6, axis=-1)]
        h = x * (1.0 + sc1) + sh1
        proj = h @ w_in[layer]
        qa, ka, va, qb, kb, vb, qc, kc, vc = jnp.split(proj, splits, axis=-1)
        oa = neighbourhood_attention(qa, ka, va, na_rpb[layer])
        ob = differential_attention(qb, kb, vb, diff_lambda[layer], diff_subln_g[layer], lambda_init)
        oc = dilated_attention(qc, kc, vc)
        mix = jnp.concatenate([oa, ob, oc], axis=-1) @ w_out[layer]
        x = layer_norm(DEEPNORM_ALPHA * x + g1 * mix, ln1_g[layer], ln1_b[layer])
        h = x * (1.0 + sc2) + sh2
        gate, up = jnp.split(h @ w_gu[layer], 2, axis=-1)
        ffn = (jax.nn.silu(gate) * up) @ w_down[layer]
        x = layer_norm(DEEPNORM_ALPHA * x + g2 * ffn, ln2_g[layer], ln2_b[layer])
    return x


def setup_inputs(seed: int = 0) -> dict:
    key = jax.random.key(seed)
    ks = jax.random.split(key, 18)
    f32 = jnp.float32
    nrm = lambda k, shape: jax.random.normal(k, shape, dtype=f32)
    return {
        'x_prompt': nrm(ks[0], (BATCH, SEQ, D_MODEL)),
        'x_sample': nrm(ks[1], (DEC_BATCH, DEC_SEQ, D_MODEL)),
        'c_prompt': nrm(ks[2], (BATCH, D_MODEL)),
        'c_sample': nrm(ks[3], (DEC_BATCH, D_MODEL)),
        'w_ada': nrm(ks[4], (DEPTH, D_MODEL, 6 * D_MODEL)) * D_MODEL ** -0.5,
        'b_ada': 0.01 * nrm(ks[5], (DEPTH, 6 * D_MODEL)),
        'w_in': nrm(ks[6], (DEPTH, D_MODEL, IN_WIDTH)) * D_MODEL ** -0.5,
        'na_rpb': 0.1 * nrm(ks[7], (DEPTH, NA_HEADS, 2 * NA_WIN_ROWS - 1, 2 * NA_WIN_COLS - 1)),
        'diff_lambda': 0.1 * nrm(ks[8], (DEPTH, 4, DIFF_QK_DIM)),
        'diff_subln_g': 1.0 + 0.02 * nrm(ks[9], (DEPTH, HEAD_DIM)),
        'w_out': nrm(ks[10], (DEPTH, MIX_WIDTH, D_MODEL)) * (MIX_WIDTH ** -0.5) * DEEPNORM_BETA,
        'ln1_g': 1.0 + 0.02 * nrm(ks[11], (DEPTH, D_MODEL)),
        'ln1_b': 0.02 * nrm(ks[12], (DEPTH, D_MODEL)),
        'w_gu': nrm(ks[13], (DEPTH, D_MODEL, 2 * FFN_HIDDEN)) * D_MODEL ** -0.5,
        'w_down': nrm(ks[14], (DEPTH, FFN_HIDDEN, D_MODEL)) * (FFN_HIDDEN ** -0.5) * DEEPNORM_BETA,
        'ln2_g': 1.0 + 0.02 * nrm(ks[15], (DEPTH, D_MODEL)),
        'ln2_b': 0.02 * nrm(ks[16], (DEPTH, D_MODEL)),
    }


def reference(x_prompt, x_sample, c_prompt, c_sample, w_ada, b_ada, w_in, na_rpb, diff_lambda,
              diff_subln_g, w_out, ln1_g, ln1_b, w_gu, w_down, ln2_g, ln2_b):
    y_prompt = encoder_trunk(x_prompt, c_prompt, w_ada, b_ada, w_in, na_rpb, diff_lambda, diff_subln_g,
                             w_out, ln1_g, ln1_b, w_gu, w_down, ln2_g, ln2_b)
    y_sample = encoder_trunk(x_sample, c_sample, w_ada, b_ada, w_in, na_rpb, diff_lambda, diff_subln_g,
                             w_out, ln1_g, ln1_b, w_gu, w_down, ln2_g, ln2_b)
    return (y_prompt, y_sample)
```

```cpp
#include <hip/hip_runtime.h>
#include <hip/hip_cooperative_groups.h>
#include <cstdio>
#include <cstdint>
#include <cmath>
namespace cg = cooperative_groups;

#define DI __device__ __forceinline__
#define LAS __attribute__((address_space(3)))
typedef unsigned short bf16_t;
typedef short bf16x8 __attribute__((ext_vector_type(8)));
typedef short s16x4 __attribute__((ext_vector_type(4)));
typedef float f32x2 __attribute__((ext_vector_type(2)));
typedef float f32x4 __attribute__((ext_vector_type(4)));
typedef float f32x16 __attribute__((ext_vector_type(16)));
typedef unsigned u32x2 __attribute__((ext_vector_type(2)));
typedef unsigned u32x4 __attribute__((ext_vector_type(4)));
typedef __bf16 bf16x2_t __attribute__((ext_vector_type(2)));

#ifndef REP_B
#define REP_B 1
#endif
#ifndef REP_AC
#define REP_AC 1
#endif
constexpr float LOG2E = 1.4426950408889634f;
constexpr int DM = 1024, TH = 65536, NQKV = 3072, FF = 2816, NGU = 5632, NSEQ = 40;
constexpr int PQ = 3136;
constexpr float LN_EPS = 1e-5f;
constexpr float ALPHA = 1.4142135623730951f;

DI unsigned cvtpk(float lo, float hi) { f32x2 v = {lo, hi}; bf16x2_t b = __builtin_convertvector(v, bf16x2_t); return __builtin_bit_cast(unsigned, b); }
DI float bf_lo(unsigned u) { return __uint_as_float(u << 16); }
DI float bf_hi(unsigned u) { return __uint_as_float(u & 0xffff0000u); }
DI float fexp2(float x) { return __builtin_amdgcn_exp2f(x); }
template <class T> DI T* opqp(T* x) { asm volatile("" : "+s"(x)); return x; }
DI int lane_now() { int x; asm volatile("v_mbcnt_lo_u32_b32 %0, -1, 0\n\tv_mbcnt_hi_u32_b32 %0, -1, %0" : "=&v"(x)); return x; }
DI void lds_barrier() { asm volatile("s_waitcnt lgkmcnt(0)\n\ts_barrier" ::: "memory"); }
DI int opq(int x) { asm volatile("" : "+v"(x)); return x; }

namespace pg8 {
constexpr int BM = 256, BK = 64, HALF = 128, HTB = HALF * BK * 2, STAGE_BYTES = 8 * HTB, NXCD = 8, WGM = 8;
DI int lds_byte(int r, int c) { const int st = (r >> 4) * 2 + (c >> 5), rr = r & 15, cc = c & 31, ob = rr * 64 + cc * 2; return st * 1024 + (ob ^ (((ob >> 9) & 1) << 5)); }
DI void stage_rc(int b, int& R, int& C) { const int st = b / 1024, sb = b % 1024, swz = sb ^ (((sb >> 9) & 1) << 5); R = (st >> 1) * 16 + swz / 64; C = (st & 1) * 32 + (swz % 64) / 2; }
DI int perm32(int rho) { const int n = rho >> 4, i = rho & 15; return 8 * (i >> 2) + 4 * n + (i & 3); }
struct Unit { int pm, pn; };
struct Gemm { const bf16_t* A; const bf16_t* Bt; int M, N, K; };
struct StaticOrder {
    int nM, nN, nwg, G, c;
    DI void init(int M, int N, int G_, int c_) { nM = M / BM; nN = N / BM; nwg = nM * nN; G = G_; c = c_; }
    DI bool next(int i, Unit& u) const {
        const long L = (long)i * G + c; if (L >= nwg) return false;
        int wgid = (int)L; { const int q = nwg / NXCD, r = nwg % NXCD, xcd = wgid % NXCD, off = wgid / NXCD; wgid = (xcd < r ? xcd * (q + 1) : r * (q + 1) + (xcd - r) * q) + off; }
        const int nig = WGM * nN, gid = wgid / nig, fm = gid * WGM, gsz = (nM - fm) < WGM ? (nM - fm) : WGM;
        u.pm = fm + ((wgid % nig) % gsz); u.pn = (wgid % nig) / gsz; return true;
    }
};
template <class Epi>
DI void gemm_phase(LAS unsigned char* lds, const Gemm g, const StaticOrder& S, const Epi& E, int wid) {
    const int lane = lane_now(), tid = wid * 64 + lane, wr = wid >> 2, wc = wid & 3, fr = lane & 15, fq = lane >> 4;
    const int K = g.K, nt = K / BK;
    unsigned voffA[2], voffB[2];
#pragma unroll
    for (int i = 0; i < 2; ++i) { int R, C; stage_rc(tid * 16 + i * 8192, R, C); const int Rb = (R & ~31) + perm32(R & 31);
        voffA[i] = (unsigned)(R * K + C) * 2u; voffB[i] = (unsigned)(Rb * K + C) * 2u; }
    const size_t kstep = (size_t)(BK * 2);
    const size_t hstep = (size_t)HALF * K * 2;
    const size_t tstep = 2 * hstep;
    const unsigned ldsw = (unsigned)wid * 1024u;
    const int aoff = lds_byte(wr * 64 + fr, fq * 8), boff = lds_byte(wc * 32 + fr, fq * 8);
#define PG8_SA(b, h) (((b) * 2 + (h)) * HTB)
#define PG8_SB(b, h) ((4 + (b) * 2 + (h)) * HTB)
#define PG8_STAGE(bufoff, gbase, voff) do { _Pragma("unroll") for (int _i = 0; _i < 2; ++_i) \
        __builtin_amdgcn_global_load_lds((const unsigned*)((const char*)(gbase) + (voff)[_i]), (LAS unsigned*)(lds + (bufoff) + ldsw + _i * 8192), 16, 0, 0); } while (0)
#define PG8_LDA(dst, b, h) do { _Pragma("unroll") for (int m = 0; m < 4; ++m) _Pragma("unroll") for (int k = 0; k < 2; ++k) dst[m][k] = *(const LAS bf16x8*)(lds + PG8_SA(b, h) + aoff + m * 2048 + k * 1024); } while (0)
#define PG8_LDB(dst, b, h) do { _Pragma("unroll") for (int n = 0; n < 2; ++n) _Pragma("unroll") for (int k = 0; k < 2; ++k) dst[n][k] = *(const LAS bf16x8*)(lds + PG8_SB(b, h) + boff + n * 2048 + k * 1024); } while (0)
#define PG8_MMA(ai, bj, At, Bt) do { __builtin_amdgcn_s_setprio(1); _Pragma("unroll") for (int m = 0; m < 4; ++m) _Pragma("unroll") for (int n = 0; n < 2; ++n) _Pragma("unroll") for (int k = 0; k < 2; ++k) \
        acc[ai][bj][m][n] = __builtin_amdgcn_mfma_f32_16x16x32_bf16(Bt[n][k], At[m][k], acc[ai][bj][m][n], 0, 0, 0); __builtin_amdgcn_s_setprio(0); } while (0)
#define PG8_WAIT_V(n) asm volatile("s_waitcnt vmcnt(" #n ")" ::: "memory")
#define PG8_WAIT_L(n) asm volatile("s_waitcnt lgkmcnt(" #n ")" ::: "memory")
#define PG8_BAR __builtin_amdgcn_s_barrier()
#define PG8_SCHED __builtin_amdgcn_sched_barrier(0)
    Unit cur, nxt; int ui = 0;
    if (!S.next(0, cur)) return;
    f32x4 acc[2][2][4][2];
#pragma unroll
    for (int a = 0; a < 2; ++a)
#pragma unroll
        for (int b = 0; b < 2; ++b)
#pragma unroll
            for (int m = 0; m < 4; ++m)
#pragma unroll
                for (int n = 0; n < 2; ++n) acc[a][b][m][n] = (f32x4){0.f, 0.f, 0.f, 0.f};
    bf16x8 At[4][2], B0[2][2], B1[2][2];
    const char* cA = (const char*)g.A + (size_t)cur.pm * tstep; const char* cB = (const char*)g.Bt + (size_t)cur.pn * tstep;
    PG8_STAGE(PG8_SB(0, 0), cB, voffB); PG8_STAGE(PG8_SB(0, 1), cB + hstep, voffB); PG8_STAGE(PG8_SA(0, 0), cA, voffA); PG8_STAGE(PG8_SA(0, 1), cA + hstep, voffA);
    if (wr == 1) PG8_BAR;
    PG8_WAIT_V(2); PG8_BAR;
    PG8_STAGE(PG8_SB(1, 0), cB + kstep, voffB); PG8_STAGE(PG8_SA(1, 0), cA + kstep, voffA); PG8_STAGE(PG8_SB(1, 1), cB + hstep + kstep, voffB);
    PG8_WAIT_V(6); PG8_BAR;
    for (;;) {
        const bool has_next = S.next(ui + 1, nxt);
        const char* nA = has_next ? (const char*)g.A + (size_t)nxt.pm * tstep : cA; const char* nB = has_next ? (const char*)g.Bt + (size_t)nxt.pn * tstep : cB;
        for (int t = 0; t < nt; t += 2) {
            const bool last = (t == nt - 2);
            const char* a1 = cA + (size_t)(t + 1) * kstep;
            const char* a2 = last ? nA : cA + (size_t)(t + 2) * kstep; const char* b2 = last ? nB : cB + (size_t)(t + 2) * kstep;
            const char* a3 = a2 + kstep; const char* b3 = b2 + kstep;
            PG8_LDB(B0, 0, 0); PG8_LDB(B1, 0, 1); PG8_SCHED; PG8_LDA(At, 0, 0); PG8_STAGE(PG8_SA(1, 1), a1 + hstep, voffA);
            PG8_WAIT_V(8); PG8_WAIT_L(0); PG8_BAR; PG8_MMA(0, 0, At, B0); PG8_MMA(0, 1, At, B1); PG8_BAR; PG8_SCHED;
            PG8_LDA(At, 0, 1); PG8_STAGE(PG8_SB(0, 0), b2, voffB); PG8_STAGE(PG8_SB(0, 1), b2 + hstep, voffB); PG8_STAGE(PG8_SA(0, 0), a2, voffA);
            PG8_WAIT_V(8); PG8_WAIT_L(0); PG8_BAR; PG8_MMA(1, 0, At, B0); PG8_MMA(1, 1, At, B1); PG8_BAR; PG8_SCHED;
            PG8_LDB(B0, 1, 0); PG8_LDB(B1, 1, 1); PG8_SCHED; PG8_LDA(At, 1, 0); PG8_STAGE(PG8_SA(0, 1), a2 + hstep, voffA);
            PG8_WAIT_V(8); PG8_WAIT_L(0); PG8_BAR; PG8_MMA(0, 0, At, B0); PG8_MMA(0, 1, At, B1); PG8_BAR; PG8_SCHED;
            PG8_LDA(At, 1, 1); PG8_STAGE(PG8_SB(1, 0), b3, voffB); PG8_STAGE(PG8_SB(1, 1), b3 + hstep, voffB); PG8_STAGE(PG8_SA(1, 0), a3, voffA);
            PG8_WAIT_V(8); PG8_WAIT_L(0); PG8_BAR; PG8_MMA(1, 0, At, B0); PG8_MMA(1, 1, At, B1); PG8_BAR; PG8_SCHED;
        }
        if (wr == 0) PG8_BAR;
        E(acc, cur, wr, wc, fr, fq);
        if (!has_next) break;
#pragma unroll
        for (int a = 0; a < 2; ++a)
#pragma unroll
            for (int b = 0; b < 2; ++b)
#pragma unroll
                for (int m = 0; m < 4; ++m)
#pragma unroll
                    for (int n = 0; n < 2; ++n) acc[a][b][m][n] = (f32x4){0.f, 0.f, 0.f, 0.f};
        cur = nxt; cA = nA; cB = nB; ++ui;
        if (wr == 1) PG8_BAR;
    }
    PG8_WAIT_V(0);
    PG8_BAR;
#undef PG8_SA
#undef PG8_SB
#undef PG8_STAGE
#undef PG8_LDA
#undef PG8_LDB
#undef PG8_MMA
#undef PG8_WAIT_V
#undef PG8_WAIT_L
#undef PG8_BAR
#undef PG8_SCHED
}

struct EpiQKV {
    bf16_t* P; const float* cosC; const float* sinC; const float* cosB; const float* sinB; int Smask; LAS unsigned char* scr;
    DI void operator()(const f32x4 (&acc)[2][2][4][2], const Unit& u, int wr, int wc, int fr, int fq) const {
        const int pn = u.pn; const int row0 = u.pm * BM + wr * 64;
        const int kind = (pn == 3 || pn == 4) ? 1 : ((pn >= 6 && pn <= 9) ? 2 : 0);
        const float sc = (pn == 0 || pn == 6 || pn == 7) ? 0.125f * LOG2E : (pn == 3 ? 0.17677669529663687f * LOG2E : 1.f);
        LAS unsigned char* stg = scr + (wr * 4 + wc) * 2560;
        const int lane = fq * 16 + fr;
        const int off1 = (kind == 1) ? ((fq >> 1) * 32 + 8 * (fq & 1)) * 2 : (8 * fq) * 2;
        const int off2 = off1 + ((kind == 1) ? 32 : 64);
        const float* ct = (kind == 2) ? cosC : cosB; const float* st = (kind == 2) ? sinC : sinB;
        const int nf = (kind == 2) ? 32 : 16; const int i0 = (kind == 2) ? 8 * fq : 8 * (fq & 1);
#pragma unroll
        for (int b0 = 0; b0 < 8; b0 += 2) {
            f32x4 tc0[2], tc1[2], ts0[2], ts1[2];
            if (kind != 0) {
#pragma unroll
                for (int q = 0; q < 2; ++q) { const int idx = b0 + q; const int pos = (row0 + (idx >> 2) * HALF + (idx & 3) * 16 + fr) & Smask;
                    tc0[q] = *(const f32x4*)(ct + (size_t)pos * nf + i0); tc1[q] = *(const f32x4*)(ct + (size_t)pos * nf + i0 + 4);
                    ts0[q] = *(const f32x4*)(st + (size_t)pos * nf + i0); ts1[q] = *(const f32x4*)(st + (size_t)pos * nf + i0 + 4); }
            }
#pragma unroll
            for (int q = 0; q < 2; ++q) { const int idx = b0 + q, ai = idx >> 2, m = idx & 3; const int rbase = row0 + ai * HALF + m * 16;
                f32x4 a0 = acc[ai][0][m][0], a1 = acc[ai][0][m][1], b0v = acc[ai][1][m][0], b1v = acc[ai][1][m][1];
                if (kind != 0) {
                    const f32x4 c0 = tc0[q], c1 = tc1[q], s0 = ts0[q], s1 = ts1[q];
                    const f32x4 o10 = a0 * c0 - b0v * s0, o11 = a1 * c1 - b1v * s1, o20 = a0 * s0 + b0v * c0, o21 = a1 * s1 + b1v * c1;
                    a0 = o10; a1 = o11; b0v = o20; b1v = o21;
                }
                a0 = a0 * sc; a1 = a1 * sc; b0v = b0v * sc; b1v = b1v * sc;
                u32x4 w1, w2; w1.x = cvtpk(a0[0], a0[1]); w1.y = cvtpk(a0[2], a0[3]); w1.z = cvtpk(a1[0], a1[1]); w1.w = cvtpk(a1[2], a1[3]);
                w2.x = cvtpk(b0v[0], b0v[1]); w2.y = cvtpk(b0v[2], b0v[3]); w2.z = cvtpk(b1v[0], b1v[1]); w2.w = cvtpk(b1v[2], b1v[3]);
                *(LAS u32x4*)(stg + fr * 144 + off1) = w1; *(LAS u32x4*)(stg + fr * 144 + off2) = w2;
                asm volatile("s_waitcnt lgkmcnt(0)" ::: "memory");
                bf16_t* dst = P + (size_t)rbase * PQ + pn * 256 + wc * 64;
#pragma unroll
                for (int i = 0; i < 2; ++i) { const int pc = i * 64 + lane, row = pc >> 3, ch = pc & 7;
                    const u32x4 v = *(LAS const u32x4*)(stg + row * 144 + ch * 16);
                    *(u32x4*)(dst + (size_t)row * PQ + ch * 8) = v; }
            }
        }
    }
};
template <bool RB, bool OB>
struct EpiRes {
    const void* res; void* out; const float* stats; const float* lng; const float* lnb; const float* gatebase; int Sshift;
    DI void operator()(const f32x4 (&acc)[2][2][4][2], const Unit& u, int wr, int wc, int fr, int fq) const {
        const int row0 = u.pm * BM + wr * 64 + fr; const int seq = (u.pm * BM) >> Sshift; const float* gate = gatebase + (size_t)seq * 6144;
        constexpr int NB = RB ? 4 : 2;
#pragma unroll
        for (int bj = 0; bj < 2; ++bj) { const int col = u.pn * BM + bj * HALF + wc * 32 + 8 * fq;
            const f32x4 g0 = *(const f32x4*)(gate + col), g1 = *(const f32x4*)(gate + col + 4);
            f32x4 lg0 = {1.f, 1.f, 1.f, 1.f}, lg1 = lg0, lb0 = {0.f, 0.f, 0.f, 0.f}, lb1 = lb0;
            if (stats) { lg0 = *(const f32x4*)(lng + col); lg1 = *(const f32x4*)(lng + col + 4); lb0 = *(const f32x4*)(lnb + col); lb1 = *(const f32x4*)(lnb + col + 4); }
#pragma unroll
            for (int b0 = 0; b0 < 8; b0 += NB) {
                u32x4 rw[NB]; f32x4 rf0[RB ? 1 : NB], rf1[RB ? 1 : NB]; f32x2 stv[NB];
#pragma unroll
                for (int q = 0; q < NB; ++q) { const int idx = b0 + q, ai = idx >> 2, m = idx & 3; const int row = row0 + ai * HALF + m * 16; const size_t off = (size_t)row * DM + col;
                    if (RB) rw[q] = *(const u32x4*)((const bf16_t*)res + off);
                    else { rf0[q] = __builtin_nontemporal_load((const f32x4*)((const float*)res + off)); rf1[q] = __builtin_nontemporal_load((const f32x4*)((const float*)res + off + 4)); }
                    stv[q] = stats ? *(const f32x2*)(stats + 2 * (size_t)row) : (f32x2){0.f, 1.f}; }
#pragma unroll
                for (int q = 0; q < NB; ++q) { const int idx = b0 + q, ai = idx >> 2, m = idx & 3; const int row = row0 + ai * HALF + m * 16; const size_t off = (size_t)row * DM + col;
                    f32x4 r0, r1;
                    if (RB) { const u32x4 w = rw[q]; r0 = (f32x4){bf_lo(w.x), bf_hi(w.x), bf_lo(w.y), bf_hi(w.y)}; r1 = (f32x4){bf_lo(w.z), bf_hi(w.z), bf_lo(w.w), bf_hi(w.w)}; }
                    else { r0 = rf0[q]; r1 = rf1[q]; }
                    if (stats) { const f32x2 st = stv[q]; r0 = (r0 - st.x) * st.y * lg0 + lb0; r1 = (r1 - st.x) * st.y * lg1 + lb1; }
                    const f32x4 y0 = r0 * ALPHA + g0 * acc[ai][bj][m][0], y1 = r1 * ALPHA + g1 * acc[ai][bj][m][1];
                    if (OB) { u32x4 w; w.x = cvtpk(y0[0], y0[1]); w.y = cvtpk(y0[2], y0[3]); w.z = cvtpk(y1[0], y1[1]); w.w = cvtpk(y1[2], y1[3]); *(u32x4*)((bf16_t*)out + off) = w; }
                    else { *(f32x4*)((float*)out + off) = y0; *(f32x4*)((float*)out + off + 4) = y1; } }
            } }
    }
};
struct EpiSwiGLU {
    bf16_t* O;
    DI void operator()(const f32x4 (&acc)[2][2][4][2], const Unit& u, int wr, int wc, int fr, int fq) const {
        const int row0 = u.pm * BM + wr * 64 + fr; const int col = u.pn * HALF + wc * 32 + 8 * fq;
#pragma unroll
        for (int ai = 0; ai < 2; ++ai)
#pragma unroll
            for (int m = 0; m < 4; ++m) { float a[8];
#pragma unroll
                for (int n = 0; n < 2; ++n)
#pragma unroll
                    for (int j = 0; j < 4; ++j) { const float gv = acc[ai][0][m][n][j], uv = acc[ai][1][m][n][j];
                        a[4 * n + j] = gv * __builtin_amdgcn_rcpf(1.f + fexp2(-gv * LOG2E)) * uv; }
                u32x4 w; w.x = cvtpk(a[0], a[1]); w.y = cvtpk(a[2], a[3]); w.z = cvtpk(a[4], a[5]); w.w = cvtpk(a[6], a[7]);
                *(u32x4*)(O + (size_t)(row0 + ai * HALF + m * 16) * FF + col) = w; }
    }
};
}

constexpr size_t MiB = 1u << 20;
constexpr size_t WS_MODP = 1 * MiB;
constexpr size_t WS_MODV = 17 * MiB;
constexpr size_t WS_ROPEC = 19 * MiB;
constexpr size_t WS_ROPEB = 21 * MiB;
constexpr size_t WS_STA = 22 * MiB;
constexpr size_t WS_STB = 23 * MiB;
constexpr size_t WS_W = 24 * MiB;
constexpr size_t W_IN = 0, W_OUT = 6 * MiB, W_GU = 8 * MiB, W_DOWN = 19 * MiB, W_LAYER = 25 * MiB;
constexpr size_t WS_XN = 80 * MiB;
constexpr size_t WS_PROJ = 208 * MiB;
constexpr size_t WS_PART = 600 * MiB;
constexpr size_t WS_ML = 728 * MiB;
constexpr size_t WS_YB = 736 * MiB;
constexpr size_t WS_END = 864 * MiB;
constexpr int LDS_BYTES = 131072 + 8 * 2560 + 16;
constexpr int LDS_SCR = 131072;

struct Params {
    const float* x[2]; const float* c[2];
    const float *w_ada, *b_ada, *w_in, *na_rpb, *diff_lambda, *diff_subln_g, *w_out, *ln1_g, *ln1_b, *w_gu, *w_down, *ln2_g, *ln2_b;
    float* out; unsigned char* ws;
    float invfC[32]; float invfB[16]; float lambda_init[2]; int pad[2];
};

DI int dest_row(int ptype, int ncol) {
    if (ptype == 0) {
        const int tile = ncol >> 8, a = ncol & 255;
        if (tile == 3 || tile == 4) { const int head = a >> 6, comp = (a >> 5) & 1, bj = (a >> 4) & 1, i = a & 15; return tile * 256 + bj * 128 + head * 32 + comp * 16 + i; }
        { const int head = a >> 6, bj = (a >> 5) & 1, i = a & 31; return tile * 256 + bj * 128 + head * 32 + i; }
    }
    if (ptype == 2) {
        if (ncol < FF) return (ncol >> 7) * 256 + (ncol & 127);
        const int a = ncol - FF; return (a >> 7) * 256 + 128 + (a & 127);
    }
    return ncol;
}
DI void transpose_item(const float* W, int K, int N, bf16_t* WT, int ptype, LAS float* scr, int item, int lane) {
    const int nblk = N / 32, kb = item / nblk, nb = item % nblk, k0 = 64 * kb, n0 = 32 * nb;
#pragma unroll 8
    for (int i = 0; i < 32; ++i) { const int kk = 2 * i + (lane >> 5); scr[kk * 33 + (lane & 31)] = W[(size_t)(k0 + kk) * N + n0 + (lane & 31)]; }
    asm volatile("s_waitcnt lgkmcnt(0)" ::: "memory");
    const int c = lane & 7;
#pragma unroll
    for (int j = 0; j < 4; ++j) { const int n = (lane >> 3) + 8 * j; const LAS float* s = scr + (8 * c) * 33 + n;
        u32x4 o; o.x = cvtpk(s[0 * 33], s[1 * 33]); o.y = cvtpk(s[2 * 33], s[3 * 33]); o.z = cvtpk(s[4 * 33], s[5 * 33]); o.w = cvtpk(s[6 * 33], s[7 * 33]);
        *(u32x4*)(WT + (size_t)dest_row(ptype, n0 + n) * K + k0 + 8 * c) = o; }
    asm volatile("s_waitcnt lgkmcnt(0)" ::: "memory");
}
DI float wave_sum(float v) {
#pragma unroll
    for (int o = 1; o < 64; o <<= 1) v += __shfl_xor(v, o);
    return v;
}
DI void sincos_d(float angf, float& s_out, float& c_out) {
    const double ang = (double)angf; const double kq = __builtin_rint(ang * 0.63661977236758134308);
    const double r = __builtin_fma(-kq, 1.57079632679489661923, ang) - kq * 6.123233995736766e-17; const double r2 = r * r;
    double sp = 1.0 / 6227020800.0; sp = sp * r2 - 1.0 / 39916800.0; sp = sp * r2 + 1.0 / 362880.0; sp = sp * r2 - 1.0 / 5040.0; sp = sp * r2 + 1.0 / 120.0; sp = sp * r2 - 1.0 / 6.0; sp = sp * r2 + 1.0; sp = sp * r;
    double cp = 1.0 / 479001600.0; cp = cp * r2 - 1.0 / 3628800.0; cp = cp * r2 + 1.0 / 40320.0; cp = cp * r2 - 1.0 / 720.0; cp = cp * r2 + 1.0 / 24.0; cp = cp * r2 - 0.5; cp = cp * r2 + 1.0;
    const int q = ((int)kq) & 3;
    const double sv = (q == 0) ? sp : (q == 1) ? cp : (q == 2) ? -sp : -cp;
    const double cv = (q == 0) ? cp : (q == 1) ? -sp : (q == 2) ? -cp : sp;
    s_out = (float)sv; c_out = (float)cv;
}

template <bool DO_LN, bool SB>
DI void ln_pass(const void* src, bf16_t* xn, float* stats, const float* lng, const float* lnb, const float* modbase, int which_sh, int Sshift, int gw, int lane) {
    auto ldrow = [&](int m, f32x4 (&d)[4]) {
        if (SB) { const u32x2* xr = (const u32x2*)((const bf16_t*)src + (size_t)m * DM) + lane;
#pragma unroll
            for (int j = 0; j < 4; ++j) { const u32x2 w = xr[64 * j]; d[j] = (f32x4){bf_lo(w.x), bf_hi(w.x), bf_lo(w.y), bf_hi(w.y)}; } }
        else { const f32x4* xr = (const f32x4*)((const float*)src + (size_t)m * DM) + lane;
#pragma unroll
            for (int j = 0; j < 4; ++j) d[j] = __builtin_nontemporal_load(xr + 64 * j); } };
    f32x4 nx[4];
    ldrow(gw, nx);
    for (int m = gw; m < TH; m += 2048) {
        f32x4 v[4];
#pragma unroll
        for (int j = 0; j < 4; ++j) v[j] = nx[j];
        if (m + 2048 < TH) ldrow(m + 2048, nx);
        float mean = 0.f, rstd = 1.f;
        if (DO_LN) {
            float s = 0.f;
#pragma unroll
            for (int j = 0; j < 4; ++j) s += (v[j].x + v[j].y) + (v[j].z + v[j].w);
            mean = wave_sum(s) * (1.f / DM); float s2 = 0.f;
#pragma unroll
            for (int j = 0; j < 4; ++j) { const f32x4 d = v[j] - mean; s2 += (d.x * d.x + d.y * d.y) + (d.z * d.z + d.w * d.w); }
            rstd = 1.0f / sqrtf(wave_sum(s2) * (1.f / DM) + LN_EPS);
            if (lane == 0) { stats[2 * (size_t)m] = mean; stats[2 * (size_t)m + 1] = rstd; }
        }
        const int seq = m >> Sshift; const float* sh = modbase + (size_t)seq * 6144 + which_sh * 1024; const float* scp = sh + 1024;
#pragma unroll
        for (int j = 0; j < 4; ++j) { const int col = 4 * lane + 256 * j; f32x4 xv = v[j];
            if (DO_LN) { const f32x4 g4 = *(const f32x4*)(lng + col), b4 = *(const f32x4*)(lnb + col); xv = (xv - mean) * rstd * g4 + b4; }
            const f32x4 s4 = *(const f32x4*)(scp + col), h4 = *(const f32x4*)(sh + col);
            const f32x4 hv = xv * (s4 + 1.0f) + h4;
            u32x2 w; w.x = cvtpk(hv.x, hv.y); w.y = cvtpk(hv.z, hv.w);
            *(u32x2*)(xn + (size_t)m * DM + col) = w; }
    }
}
DI void final_ln(float* io, const float* lng, const float* lnb, int gw, int lane) {
    f32x4 nx[4];
    { const f32x4* xr0 = (const f32x4*)(io + (size_t)gw * DM) + lane;
#pragma unroll
      for (int j = 0; j < 4; ++j) nx[j] = xr0[64 * j]; }
    for (int m = gw; m < TH; m += 2048) {
        f32x4* xr = (f32x4*)(io + (size_t)m * DM) + lane;
        f32x4 v[4];
#pragma unroll
        for (int j = 0; j < 4; ++j) v[j] = nx[j];
        if (m + 2048 < TH) { const f32x4* xn_ = (const f32x4*)(io + (size_t)(m + 2048) * DM) + lane;
#pragma unroll
            for (int j = 0; j < 4; ++j) nx[j] = xn_[64 * j]; }
        float s = 0.f;
#pragma unroll
        for (int j = 0; j < 4; ++j) s += (v[j].x + v[j].y) + (v[j].z + v[j].w);
        const float mean = wave_sum(s) * (1.f / DM); float s2 = 0.f;
#pragma unroll
        for (int j = 0; j < 4; ++j) { const f32x4 d = v[j] - mean; s2 += (d.x * d.x + d.y * d.y) + (d.z * d.z + d.w * d.w); }
        const float rstd = 1.0f / sqrtf(wave_sum(s2) * (1.f / DM) + LN_EPS);
#pragma unroll
        for (int j = 0; j < 4; ++j) { const int col = 4 * lane + 256 * j; const f32x4 g4 = *(const f32x4*)(lng + col), b4 = *(const f32x4*)(lnb + col);
            __builtin_nontemporal_store((v[j] - mean) * rstd * g4 + b4, xr + 64 * j); }
    }
}

DI int crow(int r, int hi) { return (r & 3) + 8 * (r >> 2) + 4 * hi; }
DI int vbyte(int key, int chunk) { return (chunk >> 2) * 4096 + (key >> 4) * 1024 + (key & 15) * 64 + (chunk & 3) * 16; }
DI int kbyte(int key, int chunk) { return chunk * 1024 + (key >> 4) * 256 + (((key + 2 * chunk) & 15) << 4); }
DI float max3f(float a, float b, float c) { float r; asm("v_max3_f32 %0, %1, %2, %3" : "=v"(r) : "v"(a), "v"(b), "v"(c)); return r; }
DI float max2f(float a, float b) { float r; asm("v_max_f32_e32 %0, %1, %2" : "=v"(r) : "v"(a), "v"(b)); return r; }
DI float rowmax32(const f32x16& p0, const f32x16& p1) {
    float a = max3f(p0[0], p0[1], p1[0]), b = max3f(p0[2], p0[3], p1[1]); a = max3f(a, p1[2], p1[3]);
#pragma unroll
    for (int r = 4; r < 16; r += 4) { a = max3f(a, p0[r], p0[r + 1]); b = max3f(b, p0[r + 2], p0[r + 3]); a = max3f(a, p1[r], p1[r + 1]); b = max3f(b, p1[r + 2], p1[r + 3]); }
    return max2f(a, b);
}
DI float xhalf_max(float v) { auto rr = __builtin_amdgcn_permlane32_swap(__float_as_uint(v), __float_as_uint(v), false, false); return max2f(__uint_as_float(rr[0]), __uint_as_float(rr[1])); }
DI float xhalf_sum(float v) { auto rr = __builtin_amdgcn_permlane32_swap(__float_as_uint(v), __float_as_uint(v), false, false); return __uint_as_float(rr[0]) + __uint_as_float(rr[1]); }
typedef short v4i16_t __attribute__((ext_vector_type(4)));
DI s16x4 vtr(LAS const unsigned char* p) { return __builtin_bit_cast(s16x4, __builtin_amdgcn_ds_read_tr16_b64_v4i16((LAS v4i16_t*)p)); }

template <int ND0, int D0OFF>
DI void qk64(f32x16& p0, f32x16& p1, LAS const unsigned char* kslot, const bf16x8* qr, int r32, int hi) {
    bf16x8 kf[2 * ND0];
#pragma unroll
    for (int d0 = 0; d0 < ND0; ++d0) {
        LAS const unsigned char* kp = kslot + kbyte(r32, 2 * (D0OFF + d0) + hi);
        kf[2 * d0] = *(LAS const bf16x8*)kp; kf[2 * d0 + 1] = *(LAS const bf16x8*)(kp + 512);
    }
    __builtin_amdgcn_sched_barrier(0);
    f32x16 a, b;
#pragma unroll
    for (int i = 0; i < 16; ++i) { a[i] = 0.f; b[i] = 0.f; }
#pragma unroll
    for (int d0 = 0; d0 < ND0; ++d0) {
        a = __builtin_amdgcn_mfma_f32_32x32x16_bf16(kf[2 * d0], qr[D0OFF + d0], a, 0, 0, 0);
        b = __builtin_amdgcn_mfma_f32_32x32x16_bf16(kf[2 * d0 + 1], qr[D0OFF + d0], b, 0, 0, 0);
    }
    p0 = a; p1 = b;
}
DI void softmax_pv(f32x16& p0, f32x16& p1, float& m, float& l, f32x16& o0, f32x16& o1, LAS const unsigned char* vslot, int lane, int hi) {
    LAS const unsigned char* vp = vslot + ((lane >> 4) & 1) * 32 + (lane & 3) * 8 + (4 * hi + ((lane & 15) >> 2)) * 64;
    s16x4 vlo0[4], vhi0[4], vlo1[4], vhi1[4];
#pragma unroll
    for (int ks = 0; ks < 4; ++ks) { vlo0[ks] = vtr(vp + ks * 1024); vhi0[ks] = vtr(vp + ks * 1024 + 512); vlo1[ks] = vtr(vp + 4096 + ks * 1024); vhi1[ks] = vtr(vp + 4096 + ks * 1024 + 512); }
    __builtin_amdgcn_sched_barrier(0);
    const float mx = xhalf_max(rowmax32(p0, p1));
    const float mn = max2f(m, mx); const float f = fexp2(m - mn); m = mn;
    float s = 0.f;
#pragma unroll
    for (int r = 0; r < 16; ++r) { p0[r] = fexp2(p0[r] - mn); p1[r] = fexp2(p1[r] - mn); s += p0[r] + p1[r]; }
    s = xhalf_sum(s);
    l = l * f + s;
#pragma unroll
    for (int r = 0; r < 16; ++r) { o0[r] *= f; o1[r] *= f; }
    u32x4 pw[4];
    pw[0] = (u32x4){cvtpk(p0[0], p0[1]), cvtpk(p0[2], p0[3]), cvtpk(p0[4], p0[5]), cvtpk(p0[6], p0[7])};
    pw[1] = (u32x4){cvtpk(p0[8], p0[9]), cvtpk(p0[10], p0[11]), cvtpk(p0[12], p0[13]), cvtpk(p0[14], p0[15])};
    pw[2] = (u32x4){cvtpk(p1[0], p1[1]), cvtpk(p1[2], p1[3]), cvtpk(p1[4], p1[5]), cvtpk(p1[6], p1[7])};
    pw[3] = (u32x4){cvtpk(p1[8], p1[9]), cvtpk(p1[10], p1[11]), cvtpk(p1[12], p1[13]), cvtpk(p1[14], p1[15])};
#pragma unroll
    for (int ks = 0; ks < 4; ++ks) {
        const bf16x8 v0 = (bf16x8){vlo0[ks][0], vlo0[ks][1], vlo0[ks][2], vlo0[ks][3], vhi0[ks][0], vhi0[ks][1], vhi0[ks][2], vhi0[ks][3]};
        const bf16x8 v1 = (bf16x8){vlo1[ks][0], vlo1[ks][1], vlo1[ks][2], vlo1[ks][3], vhi1[ks][0], vhi1[ks][1], vhi1[ks][2], vhi1[ks][3]};
        const bf16x8 pf = __builtin_bit_cast(bf16x8, pw[ks]);
        o0 = __builtin_amdgcn_mfma_f32_32x32x16_bf16(v0, pf, o0, 0, 0, 0);
        o1 = __builtin_amdgcn_mfma_f32_32x32x16_bf16(v1, pf, o1, 0, 0, 0);
    }
}
DI f32x16 zero16() { f32x16 z;
#pragma unroll
    for (int i = 0; i < 16; ++i) z[i] = 0.f;
    return z; }
DI void store_oT(bf16_t* dst_row  , const f32x16& o0, const f32x16& o1, int hi) {
#pragma unroll
    for (int g = 0; g < 4; ++g) {
        u32x2 w0; w0.x = cvtpk(o0[4 * g], o0[4 * g + 1]); w0.y = cvtpk(o0[4 * g + 2], o0[4 * g + 3]);
        u32x2 w1; w1.x = cvtpk(o1[4 * g], o1[4 * g + 1]); w1.y = cvtpk(o1[4 * g + 2], o1[4 * g + 3]);
        *(u32x2*)(dst_row + 8 * g + 4 * hi) = w0; *(u32x2*)(dst_row + 32 + 8 * g + 4 * hi) = w1;
    }
}

constexpr int STG_ROW = 144, STG_BYTES = 5120, STG_OFF = 65536, STG_SC = 4608;
DI void stage_oT(LAS unsigned char* stg, const f32x16& o0, const f32x16& o1, int r32, int hi) {
#pragma unroll
    for (int g = 0; g < 4; ++g) {
        u32x2 w0; w0.x = cvtpk(o0[4 * g], o0[4 * g + 1]); w0.y = cvtpk(o0[4 * g + 2], o0[4 * g + 3]);
        u32x2 w1; w1.x = cvtpk(o1[4 * g], o1[4 * g + 1]); w1.y = cvtpk(o1[4 * g + 2], o1[4 * g + 3]);
        *(LAS u32x2*)(stg + r32 * STG_ROW + (8 * g + 4 * hi) * 2) = w0; *(LAS u32x2*)(stg + r32 * STG_ROW + 64 + (8 * g + 4 * hi) * 2) = w1;
    }
}
DI void flush_rows(LAS const unsigned char* stg, bf16_t* dst0, size_t row_stride, int lane) {
    asm volatile("s_waitcnt lgkmcnt(0)" ::: "memory");
#pragma unroll
    for (int i = 0; i < 4; ++i) { const int pc = i * 64 + lane, row = pc >> 3, ch = pc & 7;
        const u32x4 v = *(LAS const u32x4*)(stg + row * STG_ROW + ch * 16);
        *(u32x4*)(dst0 + (size_t)row * row_stride + ch * 8) = v; }
}

DI void attn_na_unit(int ua, int S, int layer, const bf16_t* PROJ, bf16_t* O, const float* rpb, LAS unsigned char* wl, LAS float* bias, int lane) {
    const int r32 = lane & 31, hi = lane >> 5;
    const int R = S >> 6;
    const int half_c = ua & 1; const int t1 = ua >> 1; const int r = t1 % R; const int t2 = t1 / R; const int head = t2 & 3; const int seq = t2 >> 2;
    const size_t seqrow = (size_t)seq * S;
    const int c = 32 * half_c + r32; const int cs = min(max(c - 8, 0), 48); const int rs = min(max(r - 4, 0), R - 8);
    const bf16_t* Qp = PROJ + (seqrow + (size_t)r * 64 + c) * PQ + head * 64;
    bf16x8 qr[4];
#pragma unroll
    for (int d0 = 0; d0 < 4; ++d0) qr[d0] = *(const bf16x8*)(Qp + 16 * d0 + 8 * hi);
    for (int i = lane; i < 465; i += 64) bias[i] = rpb[(size_t)(layer * 4 + head) * 465 + i] * LOG2E;
    const bf16_t* Kb = PROJ + seqrow * PQ + 256 + head * 64; const bf16_t* Vb = PROJ + seqrow * PQ + 512 + head * 64;
    float m = -1e30f, l = 0.f; f32x16 o0 = zero16(), o1 = zero16();
    u32x4 kreg[8], vreg[8];
    {   const size_t tb = (size_t)rs * 64;
#pragma unroll
        for (int i = 0; i < 8; ++i) { kreg[i] = *(const u32x4*)(Kb + (tb + 8 * i + (lane >> 3)) * PQ + 8 * (lane & 7));
            vreg[i] = *(const u32x4*)(Vb + (tb + 16 * (i & 3) + (lane >> 2)) * PQ + 32 * (i >> 2) + 8 * (lane & 3)); } }
    for (int j = 0; j < 8; ++j) {
        const int kr = rs + j;
#pragma unroll
        for (int i = 0; i < 8; ++i) { *(LAS u32x4*)(wl + kbyte(8 * i + (lane >> 3), lane & 7)) = kreg[i]; *(LAS u32x4*)(wl + 8192 + i * 1024 + lane * 16) = vreg[i]; }
        asm volatile("s_waitcnt lgkmcnt(0)" ::: "memory");
        if (j + 1 < 8) { const size_t tb = (size_t)(kr + 1) * 64;
#pragma unroll
            for (int i = 0; i < 8; ++i) { kreg[i] = *(const u32x4*)(Kb + (tb + 8 * i + (lane >> 3)) * PQ + 8 * (lane & 7));
                vreg[i] = *(const u32x4*)(Vb + (tb + 16 * (i & 3) + (lane >> 2)) * PQ + 32 * (i >> 2) + 8 * (lane & 3)); } }
        f32x16 p0, p1;
        qk64<4, 0>(p0, p1, wl, qr, r32, hi);
        const int dr = kr - r + 7; LAS const float* brow = bias + dr * 31;
#pragma unroll
        for (int rr = 0; rr < 16; ++rr) {
            const int k0 = crow(rr, hi), k1 = k0 + 32;
            const int i0 = min(max(k0 - c + 15, 0), 30), i1 = min(max(k1 - c + 15, 0), 30);
            const float b0 = brow[i0], b1 = brow[i1];
            p0[rr] = (k0 >= cs && k0 < cs + 16) ? p0[rr] + b0 : -INFINITY;
            p1[rr] = (k1 >= cs && k1 < cs + 16) ? p1[rr] + b1 : -INFINITY;
        }
        softmax_pv(p0, p1, m, l, o0, o1, wl + 8192, lane, hi);
        asm volatile("s_waitcnt lgkmcnt(0)" ::: "memory");
    }
    const float inv = 1.0f / l;
#pragma unroll
    for (int i = 0; i < 16; ++i) { o0[i] *= inv; o1[i] *= inv; }
    store_oT(O + (seqrow + (size_t)r * 64 + c) * DM + head * 64, o0, o1, hi);
}

template <int MODE>
DI void attn_dil_unit(int uc, int S, int dsh  , int slot, const bf16_t* PROJ, bf16_t* O, bf16_t* PART, float* ML, LAS unsigned char* wl, int lane) {
    const int r32 = lane & 31, hi = lane >> 5;
    const int upsh = S >> 5;
    const int j = uc % upsh; const int t2 = uc / upsh; const int head = t2 & 7; const int seq = t2 >> 3;
    const int L = S >> dsh; const int bps = L >> 5; const int rho = j / bps; const int a = j % bps;
    const size_t seqrow = (size_t)seq * S;
    const int nq = 32 * a + r32; const size_t qrow = seqrow + ((size_t)nq << dsh) + rho;
    const bf16_t* Qp = PROJ + qrow * PQ + 1536 + head * 64;
    bf16x8 qr[4];
#pragma unroll
    for (int d0 = 0; d0 < 4; ++d0) qr[d0] = *(const bf16x8*)(Qp + 16 * d0 + 8 * hi);
    const bf16_t* Kb = PROJ + seqrow * PQ + 2048 + head * 64; const bf16_t* Vb = PROJ + seqrow * PQ + 2560 + head * 64;
    float m = -1e30f, l = 0.f; f32x16 o0 = zero16(), o1 = zero16();
    u32x4 kreg[8], vreg[8];
#define DIL_LOAD(n0_) do { \
        _Pragma("unroll") for (int i = 0; i < 8; ++i) { const int nk_ = min(max((n0_) + 8 * i + (lane >> 3), 0), L - 1); \
            kreg[i] = *(const u32x4*)(Kb + (((size_t)nk_ << dsh) + rho) * PQ + 8 * (lane & 7)); \
            const int nv_ = min(max((n0_) + 16 * (i & 3) + (lane >> 2), 0), L - 1); \
            vreg[i] = *(const u32x4*)(Vb + (((size_t)nv_ << dsh) + rho) * PQ + 32 * (i >> 2) + 8 * (lane & 3)); } } while (0)
    DIL_LOAD(32 * a - 64);
    for (int t = 0; t < 3; ++t) {
        const int n0 = 32 * a - 64 + 64 * t;
#pragma unroll
        for (int i = 0; i < 8; ++i) { *(LAS u32x4*)(wl + kbyte(8 * i + (lane >> 3), lane & 7)) = kreg[i]; *(LAS u32x4*)(wl + 8192 + i * 1024 + lane * 16) = vreg[i]; }
        asm volatile("s_waitcnt lgkmcnt(0)" ::: "memory");
        if (t + 1 < 3) DIL_LOAD(n0 + 64);
        f32x16 p0, p1;
        qk64<4, 0>(p0, p1, wl, qr, r32, hi);
#pragma unroll
        for (int rr = 0; rr < 16; ++rr) {
            const int k0 = n0 + crow(rr, hi), k1 = k0 + 32;
            const int d0 = nq - k0, d1 = nq - k1;
            p0[rr] = (d0 <= 64 && d0 >= -64 && k0 >= 0 && k0 < L) ? p0[rr] : -INFINITY;
            p1[rr] = (d1 <= 64 && d1 >= -64 && k1 >= 0 && k1 < L) ? p1[rr] : -INFINITY;
        }
        softmax_pv(p0, p1, m, l, o0, o1, wl + 8192, lane, hi);
        asm volatile("s_waitcnt lgkmcnt(0)" ::: "memory");
    }
#undef DIL_LOAD
    if (MODE == 0) {
        const float inv = 1.0f / l;
#pragma unroll
        for (int i = 0; i < 16; ++i) { o0[i] *= inv; o1[i] *= inv; }
        store_oT(PART + (((size_t)slot * TH + qrow) * 8 + head) * 64, o0, o1, hi);
        if (hi == 0) { f32x2 ml = {m, l}; *(f32x2*)(ML + (((size_t)slot * TH + qrow) * 8 + head) * 2) = ml; }
    } else {
        const f32x2 ml4 = *(const f32x2*)(ML + (((size_t)0 * TH + qrow) * 8 + head) * 2);
        const f32x2 ml16 = *(const f32x2*)(ML + (((size_t)1 * TH + qrow) * 8 + head) * 2);
        const float mall = fmaxf(m, fmaxf(ml4.x, ml16.x));
        const float w1 = fexp2(m - mall), w4 = fexp2(ml4.x - mall) * ml4.y, w16 = fexp2(ml16.x - mall) * ml16.y;
        const float inv = 1.0f / (w1 * l + w4 + w16);
        const bf16_t* P4 = PART + (((size_t)0 * TH + qrow) * 8 + head) * 64; const bf16_t* P16 = PART + (((size_t)1 * TH + qrow) * 8 + head) * 64;
#pragma unroll
        for (int g = 0; g < 4; ++g) {
            const u32x2 a0 = *(const u32x2*)(P4 + 8 * g + 4 * hi), a1 = *(const u32x2*)(P4 + 32 + 8 * g + 4 * hi);
            const u32x2 b0 = *(const u32x2*)(P16 + 8 * g + 4 * hi), b1 = *(const u32x2*)(P16 + 32 + 8 * g + 4 * hi);
            o0[4 * g + 0] = (w1 * o0[4 * g + 0] + w4 * bf_lo(a0.x) + w16 * bf_lo(b0.x)) * inv; o0[4 * g + 1] = (w1 * o0[4 * g + 1] + w4 * bf_hi(a0.x) + w16 * bf_hi(b0.x)) * inv;
            o0[4 * g + 2] = (w1 * o0[4 * g + 2] + w4 * bf_lo(a0.y) + w16 * bf_lo(b0.y)) * inv; o0[4 * g + 3] = (w1 * o0[4 * g + 3] + w4 * bf_hi(a0.y) + w16 * bf_hi(b0.y)) * inv;
            o1[4 * g + 0] = (w1 * o1[4 * g + 0] + w4 * bf_lo(a1.x) + w16 * bf_lo(b1.x)) * inv; o1[4 * g + 1] = (w1 * o1[4 * g + 1] + w4 * bf_hi(a1.x) + w16 * bf_hi(b1.x)) * inv;
            o1[4 * g + 2] = (w1 * o1[4 * g + 2] + w4 * bf_lo(a1.y) + w16 * bf_lo(b1.y)) * inv; o1[4 * g + 3] = (w1 * o1[4 * g + 3] + w4 * bf_hi(a1.y) + w16 * bf_hi(b1.y)) * inv;
        }
        store_oT(O + qrow * DM + 512 + head * 64, o0, o1, hi);
    }
}

#define WALK_LOADS(KR_, VR_, KROW_, VROW_) do { \
        _Pragma("unroll") for (int e = 0; e < 2; ++e) { const int i_ = 2 * w4 + e; \
            KR_[e] = *(const u32x4*)(Kb_ + (size_t)(KROW_(8 * i_ + (lane >> 3))) * PQ + 8 * (lane & 7)); \
            VR_[e] = *(const u32x4*)(Vb_ + (size_t)(VROW_(8 * i_ + (lane >> 3))) * PQ + 8 * (lane & 7)); } } while (0)
#define WALK_STORES(KR_, VR_, dst_) do { \
        _Pragma("unroll") for (int e = 0; e < 2; ++e) { const int i_ = 2 * w4 + e; \
            *(LAS u32x4*)((dst_) + kbyte(8 * i_ + (lane >> 3), lane & 7)) = KR_[e]; *(LAS u32x4*)((dst_) + 8192 + vbyte(8 * i_ + (lane >> 3), lane & 7)) = VR_[e]; } } while (0)

template <int MODE>
DI void walk_dil(int Ssh, int nseq, int dsh, int slot, const bf16_t* PROJ, bf16_t* O, bf16_t* PART, float* ML, LAS unsigned char* lds, int wid, int lane, int wgi) {
    constexpr int NW = 512; const int S = 1 << Ssh;
    const int r32 = lane & 31, hi = lane >> 5, g = wid >> 2, w4 = g ? 3 - (wid & 3) : (wid & 3);
    LAS unsigned char* wb = lds + g * 32768;
    const int L = S >> dsh, ush = Ssh - 7, bsh = Ssh - dsh - 7;
    const int F = ((nseq * 8) << ush) / NW * 4;
    u32x4 kA[2], vA[2], kB[2], vB[2]; bf16x8 qr[4], qn[4];
    float m = -1e30f, l = 0.f; f32x16 o0 = zero16(), o1 = zero16();
    int c_head = 0, c_rho = 0, c_A = 0; size_t c_seqrow = 0;
    f32x2 pml4 = {0.f, 0.f}, pml16 = {0.f, 0.f};
#define DIL_DECODE(u_, head_, rho_, A_, seqrow_) do { const int j_ = (u_) & ((1 << ush) - 1); const int t2_ = (u_) >> ush; head_ = t2_ & 7; seqrow_ = (size_t)(t2_ >> 3) << Ssh; rho_ = j_ >> bsh; A_ = j_ & ((1 << bsh) - 1); } while (0)
#define DIL_TILE_LOAD(KR_, VR_, f_) do { const int u_ = wgi + ((f_) >> 2) * NW; int h_, rho_, A_; size_t sr_; DIL_DECODE(u_, h_, rho_, A_, sr_); \
        const bf16_t* Kb_ = PROJ + sr_ * PQ + 2048 + h_ * 64; const bf16_t* Vb_ = PROJ + sr_ * PQ + 2560 + h_ * 64; const int n0_ = 128 * A_ - 64 + 64 * ((f_) & 3); \
        auto rowf = [&](int k_) { return (((size_t)min(max(n0_ + k_, 0), L - 1)) << dsh) + rho_; }; \
        WALK_LOADS(KR_, VR_, rowf, rowf); } while (0)
#define DIL_Q_LOAD(dst_, u_) do { int h_, rho_, A_; size_t sr_; DIL_DECODE(u_, h_, rho_, A_, sr_); \
        const bf16_t* Qp_ = PROJ + (sr_ + (((size_t)(128 * A_ + 32 * w4 + r32)) << dsh) + rho_) * PQ + 1536 + h_ * 64; \
        _Pragma("unroll") for (int d0 = 0; d0 < 4; ++d0) dst_[d0] = *(const bf16x8*)(Qp_ + 16 * d0 + 8 * hi); } while (0)
    DIL_TILE_LOAD(kA, vA, 0); DIL_Q_LOAD(qr, wgi);
    WALK_STORES(kA, vA, wb);
    DIL_TILE_LOAD(kB, vB, 1);
    lds_barrier();
    auto body = [&](const int f, LAS unsigned char* cur) {
        const int s = f & 3;
        if (s == 0) { DIL_DECODE(wgi + (f >> 2) * NW, c_head, c_rho, c_A, c_seqrow); m = -1e30f; l = 0.f; o0 = zero16(); o1 = zero16();
            if (MODE == 1) { const size_t qrow_ = c_seqrow + (size_t)(128 * c_A + 32 * w4 + r32);
                pml4 = *(const f32x2*)(ML + (((size_t)0 * TH + qrow_) * 8 + c_head) * 2); pml16 = *(const f32x2*)(ML + (((size_t)1 * TH + qrow_) * 8 + c_head) * 2); } }
        if (s == 1 && f + 3 < F) DIL_Q_LOAD(qn, wgi + ((f + 3) >> 2) * NW);
        const int nq = 128 * c_A + 32 * w4 + r32;
        if (s >= (w4 >> 1) && s <= (w4 >> 1) + 2) {
            const int n0 = 128 * c_A - 64 + 64 * s;
            f32x16 p0, p1;
            qk64<4, 0>(p0, p1, cur, qr, r32, hi);
            const int nq0 = 128 * c_A + 32 * w4;
            const bool allvalid = (n0 >= 0) && (n0 + 63 < L) && (nq0 + 31 - n0 <= 64) && (n0 + 63 - nq0 <= 64);
            if (!allvalid) {
                const int lo = max(nq - 64, 0), hb = min(nq + 64, L - 1);
                const unsigned ub = (unsigned)(n0 + 4 * hi - lo), wv = (unsigned)(hb - lo);
#pragma unroll
                for (int rr = 0; rr < 16; ++rr) {
                    const unsigned c0 = (unsigned)((rr & 3) + 8 * (rr >> 2));
                    p0[rr] = (ub + c0 <= wv) ? p0[rr] : -INFINITY;
                    p1[rr] = (ub + c0 + 32u <= wv) ? p1[rr] : -INFINITY;
                }
            }
            softmax_pv(p0, p1, m, l, o0, o1, cur + 8192, lane, hi);
        }
        if (s == 3) {
            const size_t qrow = c_seqrow + (((size_t)nq) << dsh) + c_rho; const int head = c_head;
            const size_t qrow0 = c_seqrow + (((size_t)(128 * c_A + 32 * w4)) << dsh) + c_rho;
            LAS unsigned char* stg = lds + STG_OFF + wid * STG_BYTES;
            if (MODE == 0) {
                const float inv = 1.0f / l;
#pragma unroll
                for (int i = 0; i < 16; ++i) { o0[i] *= inv; o1[i] *= inv; }
                stage_oT(stg, o0, o1, r32, hi);
                flush_rows(stg, PART + (((size_t)slot * TH + qrow0) * 8 + head) * 64, (size_t)512 << dsh, lane);
                if (hi == 0) { f32x2 ml = {m, l}; *(f32x2*)(ML + (((size_t)slot * TH + qrow) * 8 + head) * 2) = ml; }
            } else {
                const f32x2 ml4 = pml4, ml16 = pml16;
                const float mall = fmaxf(m, fmaxf(ml4.x, ml16.x));
                const float w1 = fexp2(m - mall), w4_ = fexp2(ml4.x - mall) * ml4.y, w16 = fexp2(ml16.x - mall) * ml16.y;
                const float inv = 1.0f / (w1 * l + w4_ + w16);
                const float s1 = w1 * inv;
#pragma unroll
                for (int i = 0; i < 16; ++i) { o0[i] *= s1; o1[i] *= s1; }
                stage_oT(stg, o0, o1, r32, hi);
                if (hi == 0) { f32x2 sc = {w4_ * inv, w16 * inv}; *(LAS f32x2*)(stg + STG_SC + r32 * 8) = sc; }
                asm volatile("s_waitcnt lgkmcnt(0)" ::: "memory");
                const bf16_t* P4 = PART + (((size_t)0 * TH + qrow0) * 8 + head) * 64; const bf16_t* P16 = PART + (((size_t)1 * TH + qrow0) * 8 + head) * 64;
                bf16_t* Od = O + qrow0 * DM + 512 + head * 64;
#pragma unroll
                for (int i = 0; i < 4; ++i) { const int pc = i * 64 + lane, row = pc >> 3, ch = pc & 7;
                    const u32x4 own = *(LAS const u32x4*)(stg + row * STG_ROW + ch * 16);
                    const f32x2 sc = *(LAS const f32x2*)(stg + STG_SC + row * 8);
                    const u32x4 a = *(const u32x4*)(P4 + (size_t)row * 512 + ch * 8), b = *(const u32x4*)(P16 + (size_t)row * 512 + ch * 8);
                    u32x4 r;
                    r.x = cvtpk(bf_lo(own.x) + sc.x * bf_lo(a.x) + sc.y * bf_lo(b.x), bf_hi(own.x) + sc.x * bf_hi(a.x) + sc.y * bf_hi(b.x));
                    r.y = cvtpk(bf_lo(own.y) + sc.x * bf_lo(a.y) + sc.y * bf_lo(b.y), bf_hi(own.y) + sc.x * bf_hi(a.y) + sc.y * bf_hi(b.y));
                    r.z = cvtpk(bf_lo(own.z) + sc.x * bf_lo(a.z) + sc.y * bf_lo(b.z), bf_hi(own.z) + sc.x * bf_hi(a.z) + sc.y * bf_hi(b.z));
                    r.w = cvtpk(bf_lo(own.w) + sc.x * bf_lo(a.w) + sc.y * bf_lo(b.w), bf_hi(own.w) + sc.x * bf_hi(a.w) + sc.y * bf_hi(b.w));
                    *(u32x4*)(Od + (size_t)row * DM + ch * 8) = r; }
            }
#pragma unroll
            for (int d0 = 0; d0 < 4; ++d0) qr[d0] = qn[d0];
        }
    };
    for (int f = 0; f < F; f += 2) {
        if (f + 2 < F) DIL_TILE_LOAD(kA, vA, f + 2);
        body(f, wb);
        WALK_STORES(kB, vB, wb + 16384);
        lds_barrier();
        if (f + 3 < F) DIL_TILE_LOAD(kB, vB, f + 3);
        body(f + 1, wb + 16384);
        if (f + 2 < F) WALK_STORES(kA, vA, wb);
        lds_barrier();
    }
#undef DIL_DECODE
#undef DIL_TILE_LOAD
#undef DIL_Q_LOAD
}

DI void walk_na(int Ssh, int nseq, int layer, const bf16_t* PROJ, bf16_t* O, const float* rpb, LAS unsigned char* lds, LAS float* bias, int wid, int lane, int wgi) {
    constexpr int NW = 512; const int S = 1 << Ssh;
    const int r32 = lane & 31, hi = lane >> 5, g = wid >> 2, w4 = g ? 3 - (wid & 3) : (wid & 3);
    LAS unsigned char* wb = lds + g * 32768;
    const int R = S >> 6, rsh = Ssh - 7;
    const int F = ((nseq * 4) << rsh) / NW * 9;
    u32x4 kA[2], vA[2], kB[2], vB[2]; bf16x8 qr[4], qn[4];
    float m = -1e30f, l = 0.f; f32x16 o0 = zero16(), o1 = zero16();
    int c_head = 0, c_r0 = 0, bias_head = -1; size_t c_seqrow = 0;
    const int half_c = w4 & 1; const int c = 32 * half_c + r32; const int cs = min(max(c - 8, 0), 48);
#define NA_DECODE(u_, head_, r0_, seqrow_) do { const int rp_ = (u_) & ((1 << rsh) - 1); const int t2_ = (u_) >> rsh; head_ = t2_ & 3; seqrow_ = (size_t)(t2_ >> 2) << Ssh; r0_ = 2 * rp_; } while (0)
#define NA_TILE_LOAD(KR_, VR_, f_) do { const int u_ = wgi + ((f_) / 9) * NW; int h_, r0_; size_t sr_; NA_DECODE(u_, h_, r0_, sr_); \
        const int kr_ = min(min(max(r0_ - 4, 0), R - 8) + (f_) % 9, R - 1); \
        const bf16_t* Kb_ = PROJ + (sr_ + (size_t)kr_ * 64) * PQ + 256 + h_ * 64; const bf16_t* Vb_ = PROJ + (sr_ + (size_t)kr_ * 64) * PQ + 512 + h_ * 64; \
        auto rowf = [&](int k_) { return k_; }; \
        WALK_LOADS(KR_, VR_, rowf, rowf); } while (0)
#define NA_Q_LOAD(dst_, u_) do { int h_, r0_; size_t sr_; NA_DECODE(u_, h_, r0_, sr_); \
        const bf16_t* Qp_ = PROJ + (sr_ + (size_t)(r0_ + (w4 >> 1)) * 64 + c) * PQ + h_ * 64; \
        _Pragma("unroll") for (int d0 = 0; d0 < 4; ++d0) dst_[d0] = *(const bf16x8*)(Qp_ + 16 * d0 + 8 * hi); } while (0)
    NA_TILE_LOAD(kA, vA, 0); NA_Q_LOAD(qr, wgi);
    WALK_STORES(kA, vA, wb);
    NA_TILE_LOAD(kB, vB, 1);
    lds_barrier();
    auto body = [&](const int f, LAS unsigned char* cur) {
        const int s = f % 9;
        if (s == 0) { NA_DECODE(wgi + (f / 9) * NW, c_head, c_r0, c_seqrow); m = -1e30f; l = 0.f; o0 = zero16(); o1 = zero16();
            if (c_head != bias_head) {
                for (int i = lane; i < 465; i += 64) bias[i] = rpb[(size_t)(layer * 4 + c_head) * 465 + i] * LOG2E;
                asm volatile("s_waitcnt lgkmcnt(0)" ::: "memory"); bias_head = c_head; } }
        if (s == 5 && f + 4 < F) NA_Q_LOAD(qn, wgi + ((f + 4) / 9) * NW);
        const int r = c_r0 + (w4 >> 1); const int rs = min(max(r - 4, 0), R - 8); const int kr = min(max(c_r0 - 4, 0), R - 8) + s;
        if (kr >= rs && kr < rs + 8) {
            f32x16 p0, p1;
            qk64<4, 0>(p0, p1, cur, qr, r32, hi);
            const int dr = kr - r + 7;
            LAS const float* bp = bias + dr * 31 + (15 - c + 4 * hi);
            const unsigned ub = (unsigned)(4 * hi - cs);
#pragma unroll
            for (int rr = 0; rr < 16; ++rr) {
                const int c0 = (rr & 3) + 8 * (rr >> 2);
                const float b0 = bp[c0], b1 = bp[c0 + 32];
                p0[rr] = (ub + (unsigned)c0 < 16u) ? p0[rr] + b0 : -INFINITY;
                p1[rr] = (ub + (unsigned)c0 + 32u < 16u) ? p1[rr] + b1 : -INFINITY;
            }
            softmax_pv(p0, p1, m, l, o0, o1, cur + 8192, lane, hi);
        }
        if (s == 8) {
            const float inv = 1.0f / l;
#pragma unroll
            for (int i = 0; i < 16; ++i) { o0[i] *= inv; o1[i] *= inv; }
            LAS unsigned char* stg = lds + STG_OFF + wid * STG_BYTES;
            stage_oT(stg, o0, o1, r32, hi);
            flush_rows(stg, O + (c_seqrow + (size_t)r * 64 + 32 * half_c) * DM + c_head * 64, (size_t)DM, lane);
#pragma unroll
            for (int d0 = 0; d0 < 4; ++d0) qr[d0] = qn[d0];
        }
    };
    for (int f = 0; f < F; f += 2) {
        if (f + 2 < F) NA_TILE_LOAD(kA, vA, f + 2);
        body(f, wb);
        WALK_STORES(kB, vB, wb + 16384);
        lds_barrier();
        if (f + 3 < F) NA_TILE_LOAD(kB, vB, f + 3);
        body(f + 1, wb + 16384);
        if (f + 2 < F) WALK_STORES(kA, vA, wb);
        lds_barrier();
    }
#undef NA_DECODE
#undef NA_TILE_LOAD
#undef NA_Q_LOAD
}

template <int D0OFF>
DI void qk64n(f32x16& p0, f32x16& p1, LAS const unsigned char* kslot, const bf16x8* qr, const f32x16& neg, int r32, int hi) {
    LAS const unsigned char* kpa = kslot + kbyte(r32, 2 * D0OFF + hi); LAS const unsigned char* kpb = kslot + kbyte(r32, 2 * D0OFF + 2 + hi);
    const bf16x8 k00 = *(LAS const bf16x8*)kpa, k01 = *(LAS const bf16x8*)(kpa + 512), k10 = *(LAS const bf16x8*)kpb, k11 = *(LAS const bf16x8*)(kpb + 512);
    f32x16 a = __builtin_amdgcn_mfma_f32_32x32x16_bf16(k00, qr[D0OFF], neg, 0, 0, 0);
    f32x16 b = __builtin_amdgcn_mfma_f32_32x32x16_bf16(k01, qr[D0OFF], neg, 0, 0, 0);
    p0 = __builtin_amdgcn_mfma_f32_32x32x16_bf16(k10, qr[D0OFF + 1], a, 0, 0, 0);
    p1 = __builtin_amdgcn_mfma_f32_32x32x16_bf16(k11, qr[D0OFF + 1], b, 0, 0, 0);
}
DI void softmax_lazy(f32x16& p0, f32x16& p1, float& m, float& l, f32x16& o0, f32x16& o1, u32x4 (&pw)[4], bool first) {
    const float mx = xhalf_max(rowmax32(p0, p1));
    if (first || __any(mx > m + 8.0f)) {
        const float mn = first ? mx : max2f(m, mx);
        const float f = fexp2(m - mn); m = mn; l *= f;
#pragma unroll
        for (int r = 0; r < 16; ++r) { o0[r] *= f; o1[r] *= f; }
    }
    float s0 = 0.f, s1 = 0.f;
#pragma unroll
    for (int r = 0; r < 16; ++r) { p0[r] = fexp2(p0[r] - m); p1[r] = fexp2(p1[r] - m); s0 += p0[r]; s1 += p1[r]; }
    l += xhalf_sum(s0 + s1);
    pw[0] = (u32x4){cvtpk(p0[0], p0[1]), cvtpk(p0[2], p0[3]), cvtpk(p0[4], p0[5]), cvtpk(p0[6], p0[7])};
    pw[1] = (u32x4){cvtpk(p0[8], p0[9]), cvtpk(p0[10], p0[11]), cvtpk(p0[12], p0[13]), cvtpk(p0[14], p0[15])};
    pw[2] = (u32x4){cvtpk(p1[0], p1[1]), cvtpk(p1[2], p1[3]), cvtpk(p1[4], p1[5]), cvtpk(p1[6], p1[7])};
    pw[3] = (u32x4){cvtpk(p1[8], p1[9]), cvtpk(p1[10], p1[11]), cvtpk(p1[12], p1[13]), cvtpk(p1[14], p1[15])};
}
DI void attn_diff_unit(int ub, int Ssh, float lam, float post, const float* subg, const bf16_t* PROJ, bf16_t* O, LAS unsigned char* lds, int wid, int lane) {
    const int r32 = lane & 31, hi = lane >> 5;
    const int S = 1 << Ssh; const int qb = ub & ((1 << (Ssh - 8)) - 1); const int t2 = ub >> (Ssh - 8); const int head = t2 & 3; const int seq = t2 >> 2;
    const size_t seqrow = (size_t)seq << Ssh;
    const size_t qrow = seqrow + (size_t)qb * 256 + wid * 32 + r32;
    const bf16_t* Qp = PROJ + qrow * PQ + 768 + head * 64;
    bf16x8 qr[4];
#pragma unroll
    for (int d0 = 0; d0 < 4; ++d0) qr[d0] = *(const bf16x8*)(Qp + 16 * d0 + 8 * hi);
    const bf16_t* Kb = PROJ + seqrow * PQ + 1024 + head * 64; const bf16_t* Vb = PROJ + seqrow * PQ + 1280 + head * 64;
    const bf16_t* ksrc = Kb + (size_t)(8 * wid + (lane >> 3)) * PQ + 8 * (lane & 7);
    const bf16_t* vsrc = Vb + (size_t)(8 * wid + (lane >> 3)) * PQ + 8 * (lane & 7);
    const int kdst = kbyte(8 * wid + (lane >> 3), lane & 7), vdst = 8192 + vbyte(8 * wid + (lane >> 3), lane & 7);
    const int NT = S >> 6;
    float mA = 0.f, mB = 0.f, lA = 0.f, lB = 0.f; f32x16 a0 = zero16(), a1 = zero16(), b0 = zero16(), b1 = zero16();
    u32x4 kA = *(const u32x4*)ksrc, vA = *(const u32x4*)vsrc;
    *(LAS u32x4*)(lds + kdst) = kA; *(LAS u32x4*)(lds + vdst) = vA;
    __syncthreads();
    const int vlane = ((lane >> 4) & 1) * 32 + (lane & 3) * 8 + (4 * hi + ((lane & 15) >> 2)) * 64;
    auto tile = [&](const int t, LAS unsigned char* cur) {
        f32x16 pa0, pa1, pb0, pb1; u32x4 pwA[4], pwB[4];
        qk64<2, 0>(pa0, pa1, cur, qr, r32, hi);
        qk64<2, 2>(pb0, pb1, cur, qr, r32, hi);
        const float mxA = xhalf_max(rowmax32(pa0, pa1)), mxB = xhalf_max(rowmax32(pb0, pb1));
        if (t == 0 || __any(mxA > mA + 8.0f || mxB > mB + 8.0f)) {
            const float nA = (t == 0) ? mxA : max2f(mA, mxA), nB = (t == 0) ? mxB : max2f(mB, mxB);
            const float fA = fexp2(mA - nA), fB = fexp2(mB - nB); mA = nA; mB = nB; lA *= fA; lB *= fB;
#pragma unroll
            for (int r = 0; r < 16; ++r) { a0[r] *= fA; a1[r] *= fA; b0[r] *= fB; b1[r] *= fB; }
        }
        float sA = 0.f, sB = 0.f;
#pragma unroll
        for (int r = 0; r < 16; ++r) { pa0[r] = fexp2(pa0[r] - mA); pa1[r] = fexp2(pa1[r] - mA); sA += pa0[r] + pa1[r]; }
        pwA[0] = (u32x4){cvtpk(pa0[0], pa0[1]), cvtpk(pa0[2], pa0[3]), cvtpk(pa0[4], pa0[5]), cvtpk(pa0[6], pa0[7])};
        pwA[1] = (u32x4){cvtpk(pa0[8], pa0[9]), cvtpk(pa0[10], pa0[11]), cvtpk(pa0[12], pa0[13]), cvtpk(pa0[14], pa0[15])};
        pwA[2] = (u32x4){cvtpk(pa1[0], pa1[1]), cvtpk(pa1[2], pa1[3]), cvtpk(pa1[4], pa1[5]), cvtpk(pa1[6], pa1[7])};
        pwA[3] = (u32x4){cvtpk(pa1[8], pa1[9]), cvtpk(pa1[10], pa1[11]), cvtpk(pa1[12], pa1[13]), cvtpk(pa1[14], pa1[15])};
        LAS const unsigned char* vp = cur + 8192 + vlane;
#pragma unroll
        for (int ks = 0; ks < 4; ++ks) {
            const s16x4 lo0 = vtr(vp + ks * 1024), hi0 = vtr(vp + ks * 1024 + 512), lo1 = vtr(vp + 4096 + ks * 1024), hi1 = vtr(vp + 4096 + ks * 1024 + 512);
            const bf16x8 v0 = (bf16x8){lo0[0], lo0[1], lo0[2], lo0[3], hi0[0], hi0[1], hi0[2], hi0[3]};
            const bf16x8 v1 = (bf16x8){lo1[0], lo1[1], lo1[2], lo1[3], hi1[0], hi1[1], hi1[2], hi1[3]};
            const bf16x8 pa = __builtin_bit_cast(bf16x8, pwA[ks]);
            a0 = __builtin_amdgcn_mfma_f32_32x32x16_bf16(v0, pa, a0, 0, 0, 0);
            a1 = __builtin_amdgcn_mfma_f32_32x32x16_bf16(v1, pa, a1, 0, 0, 0);
#pragma unroll
            for (int r = 4 * ks; r < 4 * ks + 4; ++r) { pb0[r] = fexp2(pb0[r] - mB); pb1[r] = fexp2(pb1[r] - mB); sB += pb0[r] + pb1[r]; }
        }
        lA += xhalf_sum(sA); lB += xhalf_sum(sB);
        pwB[0] = (u32x4){cvtpk(pb0[0], pb0[1]), cvtpk(pb0[2], pb0[3]), cvtpk(pb0[4], pb0[5]), cvtpk(pb0[6], pb0[7])};
        pwB[1] = (u32x4){cvtpk(pb0[8], pb0[9]), cvtpk(pb0[10], pb0[11]), cvtpk(pb0[12], pb0[13]), cvtpk(pb0[14], pb0[15])};
        pwB[2] = (u32x4){cvtpk(pb1[0], pb1[1]), cvtpk(pb1[2], pb1[3]), cvtpk(pb1[4], pb1[5]), cvtpk(pb1[6], pb1[7])};
        pwB[3] = (u32x4){cvtpk(pb1[8], pb1[9]), cvtpk(pb1[10], pb1[11]), cvtpk(pb1[12], pb1[13]), cvtpk(pb1[14], pb1[15])};
#pragma unroll
        for (int ks = 0; ks < 4; ++ks) {
            const s16x4 lo0 = vtr(vp + ks * 1024), hi0 = vtr(vp + ks * 1024 + 512), lo1 = vtr(vp + 4096 + ks * 1024), hi1 = vtr(vp + 4096 + ks * 1024 + 512);
            const bf16x8 v0 = (bf16x8){lo0[0], lo0[1], lo0[2], lo0[3], hi0[0], hi0[1], hi0[2], hi0[3]};
            const bf16x8 v1 = (bf16x8){lo1[0], lo1[1], lo1[2], lo1[3], hi1[0], hi1[1], hi1[2], hi1[3]};
            const bf16x8 pb = __builtin_bit_cast(bf16x8, pwB[ks]);
            b0 = __builtin_amdgcn_mfma_f32_32x32x16_bf16(v0, pb, b0, 0, 0, 0);
            b1 = __builtin_amdgcn_mfma_f32_32x32x16_bf16(v1, pb, b1, 0, 0, 0);
        }
    };
    for (int t = 0; t < NT; ++t) {
        LAS unsigned char* cur = lds + (t & 1) * 16384; LAS unsigned char* nxt = lds + ((t + 1) & 1) * 16384;
        if (t + 1 < NT) { kA = *(const u32x4*)(ksrc + (size_t)(t + 1) * 64 * PQ); vA = *(const u32x4*)(vsrc + (size_t)(t + 1) * 64 * PQ); }
        tile(t, cur);
        if (t + 1 < NT) { *(LAS u32x4*)(nxt + kdst) = kA; *(LAS u32x4*)(nxt + vdst) = vA; }
        __syncthreads();
    }
    const float ia = 1.0f / lA, ib = lam / lB; float ss = 0.f;
#pragma unroll
    for (int i = 0; i < 16; ++i) { a0[i] = a0[i] * ia - b0[i] * ib; a1[i] = a1[i] * ia - b1[i] * ib; ss += a0[i] * a0[i] + a1[i] * a1[i]; }
    ss = xhalf_sum(ss);
    const float rms = 1.0f / sqrtf(ss * (1.0f / 64.0f) + LN_EPS) * post;
#pragma unroll
    for (int g = 0; g < 4; ++g) { const f32x4 g0 = *(const f32x4*)(subg + 8 * g + 4 * hi), g1 = *(const f32x4*)(subg + 32 + 8 * g + 4 * hi);
#pragma unroll
        for (int jj = 0; jj < 4; ++jj) { a0[4 * g + jj] *= rms * g0[jj]; a1[4 * g + jj] *= rms * g1[jj]; } }
    store_oT(O + qrow * DM + 256 + head * 64, a0, a1, hi);
}


#define XB_TMO      128
#define XB_XCNT(j)  (256  + 64 * (j))
#define XB_XSUB(j)  (1280 + 64 * (j))
#define XB_XGEN(j)  (2304 + 64 * (j))
#define XB_TOP      3328
#define XB_TOPGEN   3392
#define XCD_BAR_WORDS 3456
#define XB_SPIN_CAP (1u << 18)
DI unsigned xb_ld(unsigned* p)              { return __hip_atomic_load(p, __ATOMIC_RELAXED, __HIP_MEMORY_SCOPE_AGENT); }
DI unsigned xb_add(unsigned* p, unsigned v) { return __hip_atomic_fetch_add(p, v, __ATOMIC_RELAXED, __HIP_MEMORY_SCOPE_AGENT); }
DI unsigned xb_xcc_id() { return (unsigned)__builtin_amdgcn_s_getreg((3 << 11) | 20) & 0xFu; }
#define XB_SPIN(cond, bar) do { unsigned _sp = 0; while (cond) { __builtin_amdgcn_s_sleep(1); \
    if ((++_sp & 255u) == 0u) { if (xb_ld(&(bar)[XB_TMO])) break; if (_sp > XB_SPIN_CAP) { atomicAdd(&(bar)[XB_TMO], 1u); break; } } } } while (0)
struct XcdBarrier { unsigned* bar; unsigned x; volatile LAS unsigned* st; int wid; };
DI XcdBarrier xcd_barrier_post(unsigned* bar, volatile LAS unsigned* st, int wid) {
    XcdBarrier b; b.bar = bar; b.x = xb_xcc_id(); b.st = st; b.wid = wid;
    if (wid == 0 && lane_now() == 0) (void)xb_add(&bar[XB_XCNT(b.x)], 1u);
    return b;
}
DI void xcd_barrier_complete(unsigned* bar, unsigned x, unsigned& nloc, unsigned& nx) {
    const unsigned G = gridDim.x * gridDim.y * gridDim.z;
    unsigned sum, cnt, mine, sp = 0u;
    for (;;) {
        sum = 0u; cnt = 0u; mine = 0u;
#pragma unroll
        for (unsigned j = 0; j < 16; ++j) { const unsigned c = xb_ld(&bar[XB_XCNT(j)]); sum += c; cnt += (c > 0u) ? 1u : 0u; mine = (j == x) ? c : mine; }
        if (sum == G) break;
        __builtin_amdgcn_s_sleep(1);
        if ((++sp & 255u) == 0u) { if (xb_ld(&bar[XB_TMO])) break; if (sp > XB_SPIN_CAP) { atomicAdd(&bar[XB_TMO], 1u); break; } }
    }
    nloc = mine > 0u ? mine : 1u; nx = cnt > 0u ? cnt : 1u;
}
DI void xcd_barrier(const XcdBarrier& b) {
    asm volatile("s_waitcnt vmcnt(0)" ::: "memory");
    __syncthreads();
    if (b.wid == 0 && lane_now() == 0) {
        unsigned* bar = b.bar;
        __builtin_amdgcn_s_waitcnt(0);
        unsigned nloc = b.st[0], nx = b.st[1];
        if (nloc == 0u) { xcd_barrier_complete(bar, b.x, nloc, nx); b.st[0] = nloc; b.st[1] = nx; }
        const unsigned old = xb_add(&bar[XB_XSUB(b.x)], 1u);
        const unsigned gen = old / nloc;
        if (old + 1u == (gen + 1u) * nloc) {
            __builtin_amdgcn_fence(__ATOMIC_RELEASE, "agent");
            asm volatile("s_waitcnt vmcnt(0)" ::: "memory");
            const unsigned og = xb_add(&bar[XB_TOP], 1u);
            const unsigned tg = og / nx;
            if (og + 1u == (tg + 1u) * nx) xb_add(&bar[XB_TOPGEN], 1u);
            else XB_SPIN(xb_ld(&bar[XB_TOPGEN]) == tg, bar);
            __builtin_amdgcn_fence(__ATOMIC_ACQUIRE, "agent");
            xb_add(&bar[XB_XGEN(b.x)], 1u);
            asm volatile("s_waitcnt vmcnt(0)" ::: "memory");
        } else {
            XB_SPIN(xb_ld(&bar[XB_XGEN(b.x)]) == gen, bar);
            __builtin_amdgcn_fence(__ATOMIC_ACQUIRE, "agent");
            asm volatile("s_waitcnt vmcnt(0)" ::: "memory");
        }
    }
    __syncthreads();
}

__global__ void __launch_bounds__(512, 2) fwd_megakernel(Params p) {
    extern __shared__ __attribute__((aligned(16))) unsigned char lds_raw[];
    cg::grid_group grid = cg::this_grid();
    LAS unsigned char* lds = (LAS unsigned char*)lds_raw;
    const int tid = threadIdx.x, lane = tid & 63, wid = __builtin_amdgcn_readfirstlane(tid >> 6);
    const int G = gridDim.x, bx = blockIdx.x;
    const int gw = bx * 8 + wid, NGW = G * 8;
    const int vbx = ((G & 7) == 0) ? (bx & 7) * (G >> 3) + (bx >> 3) : bx;
    unsigned char* ws = p.ws;
    float* modp = (float*)(ws + WS_MODP); float* modv = (float*)(ws + WS_MODV);
    float* cosC = (float*)(ws + WS_ROPEC); float* sinC = cosC + 8192 * 32; float* cosB = (float*)(ws + WS_ROPEB); float* sinB = cosB + 8192 * 16;
    float* stA = (float*)(ws + WS_STA); float* stB = (float*)(ws + WS_STB);
    bf16_t* XN = (bf16_t*)(ws + WS_XN); bf16_t* PROJ = (bf16_t*)(ws + WS_PROJ); bf16_t* ACT = PROJ;
    bf16_t* PART = (bf16_t*)(ws + WS_PART); float* ML = (float*)(ws + WS_ML); bf16_t* YB = (bf16_t*)(ws + WS_YB);
    LAS unsigned char* wl = lds + wid * 16384;
    LAS float* wscr = (LAS float*)(lds + LDS_SCR + wid * 2560);
    volatile LAS unsigned* bst = (volatile LAS unsigned*)(lds + LDS_SCR + 8 * 2560);
    if (tid < 2) bst[tid] = 0u;
    __syncthreads();
    XcdBarrier xbar = xcd_barrier_post((unsigned*)ws, bst, wid);
#define GSYNC() xcd_barrier(xbar)

#ifndef NO_P0
    {
        LAS float* scr = (LAS float*)wl;
        constexpr int I_IN = 16 * 96, I_OUT = 16 * 32, I_GU = 16 * 176, I_DN = 44 * 32, I_L = I_IN + I_OUT + I_GU + I_DN;
        for (int it = gw; it < 2 * I_L; it += NGW) {
            const int l = it / I_L; int r = it % I_L; bf16_t* wb = (bf16_t*)(ws + WS_W + (size_t)l * W_LAYER);
            if (r < I_IN) { transpose_item(p.w_in + (size_t)l * DM * NQKV, DM, NQKV, (bf16_t*)((unsigned char*)wb + W_IN), 0, scr, r, lane); continue; } r -= I_IN;
            if (r < I_OUT) { transpose_item(p.w_out + (size_t)l * DM * DM, DM, DM, (bf16_t*)((unsigned char*)wb + W_OUT), 1, scr, r, lane); continue; } r -= I_OUT;
            if (r < I_GU) { transpose_item(p.w_gu + (size_t)l * DM * NGU, DM, NGU, (bf16_t*)((unsigned char*)wb + W_GU), 2, scr, r, lane); continue; } r -= I_GU;
            transpose_item(p.w_down + (size_t)l * FF * DM, FF, DM, (bf16_t*)((unsigned char*)wb + W_DOWN), 1, scr, r, lane);
        }
        for (int e = bx * 512 + tid; e < 8192 * 48; e += G * 512) {
            float sv, cv;
            if (e < 8192 * 32) { const int pos = e >> 5, i = e & 31; const float ang = (float)pos * p.invfC[i]; sincos_d(ang, sv, cv); cosC[e] = cv; sinC[e] = sv; }
            else { const int e2 = e - 8192 * 32; const int pos = e2 >> 4, i = e2 & 15; const float ang = (float)pos * p.invfB[i]; sincos_d(ang, sv, cv); cosB[e2] = cv; sinB[e2] = sv; }
        }
        __syncthreads();
        LAS float* sl = (LAS float*)lds;
        for (int it = bx; it < 2 * 12 * 8; it += G) {
            const int ks = it & 7, cb = (it >> 3) % 12, l = it / 96;
            for (int idx = tid; idx < NSEQ * 128; idx += 512) { const int s = idx >> 7, kk = idx & 127;
                const float cvv = (s < 8) ? p.c[0][s * DM + ks * 128 + kk] : p.c[1][(s - 8) * DM + ks * 128 + kk];
                sl[idx] = cvv / (1.0f + __expf(-cvv)); }
            __syncthreads();
            float acc[NSEQ];
#pragma unroll
            for (int s = 0; s < NSEQ; ++s) acc[s] = 0.f;
            const float* wp = p.w_ada + ((size_t)l * DM + ks * 128) * 6144 + cb * 512 + tid;
            for (int kk = 0; kk < 128; kk += 4) {
                const float w0 = wp[(size_t)kk * 6144], w1 = wp[(size_t)(kk + 1) * 6144], w2 = wp[(size_t)(kk + 2) * 6144], w3 = wp[(size_t)(kk + 3) * 6144];
#pragma unroll
                for (int s = 0; s < NSEQ; ++s) { const f32x4 sv = *(LAS const f32x4*)(sl + s * 128 + kk); acc[s] += (sv.x * w0 + sv.y * w1) + (sv.z * w2 + sv.w * w3); }
            }
#pragma unroll
            for (int s = 0; s < NSEQ; ++s) modp[(((size_t)ks * 2 + l) * NSEQ + s) * 6144 + cb * 512 + tid] = acc[s];
            __syncthreads();
        }
    }
#endif
    grid.sync();
    for (int e = bx * 512 + tid; e < 2 * NSEQ * 6144; e += G * 512) {
        const int jcol = e % 6144, l = e / (NSEQ * 6144);
        float v = p.b_ada[l * 6144 + jcol];
#pragma unroll
        for (int ks = 0; ks < 8; ++ks) v += modp[(size_t)ks * 2 * NSEQ * 6144 + e];
        modv[e] = v;
    }
    GSYNC();

    pg8::StaticOrder SO;
    for (int hf = 0; hf < 2; ++hf) {
        const int S = hf ? 2048 : 8192, Sshift = hf ? 11 : 13, seq0 = hf ? 8 : 0, nseq = hf ? 32 : 8;
        const float* xin = p.x[hf]; float* outh = p.out + (size_t)hf * TH * DM;
        for (int l = 0; l < 2; ++l) {
            const unsigned char* wb = ws + WS_W + (size_t)l * W_LAYER;
            const bf16_t* Win_t = (const bf16_t*)(wb + W_IN); const bf16_t* Wout_t = (const bf16_t*)(wb + W_OUT);
            const bf16_t* Wgu_t = (const bf16_t*)(wb + W_GU); const bf16_t* Wdn_t = (const bf16_t*)(wb + W_DOWN);
            const float* modbase = modv + ((size_t)l * NSEQ + seq0) * 6144;
            if (l == 0) ln_pass<false, false>(xin, XN, stA, nullptr, nullptr, modbase, 0, Sshift, gw, lane_now());
            else ln_pass<true, true>(YB, XN, stA, p.ln2_g + (l - 1) * DM, p.ln2_b + (l - 1) * DM, modbase, 0, Sshift, gw, lane_now());
            GSYNC();
#ifndef NO_QKV
            { pg8::Gemm g{XN, Win_t, TH, NQKV, DM}; SO.init(TH, NQKV, G, bx);
              pg8::EpiQKV E{PROJ, cosC, sinC, cosB, sinB, S - 1, lds + LDS_SCR};
              pg8::gemm_phase<pg8::EpiQKV>(lds, g, SO, E, wid); }
#endif
            GSYNC();
            {
#ifndef NO_A
                for (int rep = 0; rep < REP_AC; ++rep) walk_na(Sshift, nseq, l, PROJ, XN, p.na_rpb, lds, wscr, wid, lane_now(), vbx * 2 + (wid >> 2));
#endif
#ifndef NO_C
                for (int rep = 0; rep < REP_AC; ++rep) {
                    walk_dil<0>(Sshift, nseq, 2, 0, PROJ, XN, PART, ML, lds, wid, lane_now(), vbx * 2 + (wid >> 2));
                    walk_dil<0>(Sshift, nseq, 4, 1, PROJ, XN, PART, ML, lds, wid, lane_now(), vbx * 2 + (wid >> 2)); }
#endif
                __syncthreads();
#ifndef NO_B
                float d01 = 0.f, d23 = 0.f; const float* lf = p.diff_lambda + l * 128;
                for (int i = 0; i < 32; ++i) { d01 += lf[i] * lf[32 + i]; d23 += lf[64 + i] * lf[96 + i]; }
                const float lam = __expf(d01) - __expf(d23) + p.lambda_init[l]; const float post = 1.0f - p.lambda_init[l];
                const int nB = nseq * 4 * (S >> 8);
                for (int rep = 0; rep < REP_B; ++rep)
                for (int u = vbx; u < nB; u += G) attn_diff_unit(u, Sshift, lam, post, p.diff_subln_g + l * 64, PROJ, XN, lds, wid, lane_now());
#endif
            }
            GSYNC();
            {
#ifndef NO_C1
              for (int rep = 0; rep < REP_AC; ++rep) walk_dil<1>(Sshift, nseq, 0, 0, PROJ, XN, PART, ML, lds, wid, lane_now(), vbx * 2 + (wid >> 2));
#endif
              __syncthreads(); }
            GSYNC();
#ifndef NO_RES
            { pg8::Gemm g{XN, Wout_t, TH, DM, DM}; SO.init(TH, DM, G, bx);
              if (l == 0) { pg8::EpiRes<false, true> E{xin, YB, nullptr, p.ln2_g, p.ln2_b, modbase + 2 * 1024, Sshift};
                  pg8::gemm_phase<pg8::EpiRes<false, true>>(lds, g, SO, E, wid); }
              else { pg8::EpiRes<true, true> E{YB, YB, stA, p.ln2_g + (l - 1) * DM, p.ln2_b + (l - 1) * DM, modbase + 2 * 1024, Sshift};
                  pg8::gemm_phase<pg8::EpiRes<true, true>>(lds, g, SO, E, wid); } }
#endif
            GSYNC();
            ln_pass<true, true>(YB, XN, stB, p.ln1_g + l * DM, p.ln1_b + l * DM, modbase, 3, Sshift, gw, lane_now());
            GSYNC();
#ifndef NO_GU
            { pg8::Gemm g{XN, Wgu_t, TH, NGU, DM}; SO.init(TH, NGU, G, bx);
              pg8::EpiSwiGLU E{ACT};
              pg8::gemm_phase<pg8::EpiSwiGLU>(lds, g, SO, E, wid); }
#endif
            GSYNC();
#ifndef NO_RES
            { pg8::Gemm g{ACT, Wdn_t, TH, DM, FF}; SO.init(TH, DM, G, bx);
              if (l == 0) { pg8::EpiRes<true, true> E{YB, YB, stB, p.ln1_g + l * DM, p.ln1_b + l * DM, modbase + 5 * 1024, Sshift};
                  pg8::gemm_phase<pg8::EpiRes<true, true>>(lds, g, SO, E, wid); }
              else { pg8::EpiRes<true, false> E{YB, outh, stB, p.ln1_g + l * DM, p.ln1_b + l * DM, modbase + 5 * 1024, Sshift};
                  pg8::gemm_phase<pg8::EpiRes<true, false>>(lds, g, SO, E, wid); } }
#endif
            GSYNC();
        }
        final_ln(outh, p.ln2_g + DM, p.ln2_b + DM, gw, lane_now());
    }
}

extern "C" void kernel_launch(void* const* d_in, const int* in_sizes, int n_in, void* d_out, int out_size, void* d_ws, size_t ws_size, hipStream_t stream) {
    static int grid = 0;
    if (grid == 0) {
        if (n_in != 17 || ws_size < WS_END) { fprintf(stderr, "kernel_launch: unexpected inputs (%d) or workspace (%zu < %zu)\n", n_in, ws_size, (size_t)WS_END); grid = -1; return; }
        int dev = 0, cus = 0, per_cu = 0;
        hipGetDevice(&dev); hipDeviceGetAttribute(&cus, hipDeviceAttributeMultiprocessorCount, dev);
        hipFuncSetAttribute((const void*)fwd_megakernel, hipFuncAttributeMaxDynamicSharedMemorySize, LDS_BYTES);
        hipOccupancyMaxActiveBlocksPerMultiprocessor(&per_cu, (const void*)fwd_megakernel, 512, LDS_BYTES);
        if (per_cu < 1) { fprintf(stderr, "kernel_launch: occupancy query says %d blocks per CU\n", per_cu); per_cu = 1; }
        (void)hipGetLastError();
        if (cus != 256) { fprintf(stderr, "kernel_launch: built for a 256-CU device (got %d)\n", cus); grid = -1; return; }
        grid = 256;
    }
    if (grid < 0) return;
    Params p{};
    p.x[0] = (const float*)d_in[0]; p.x[1] = (const float*)d_in[1]; p.c[0] = (const float*)d_in[2]; p.c[1] = (const float*)d_in[3];
    p.w_ada = (const float*)d_in[4]; p.b_ada = (const float*)d_in[5]; p.w_in = (const float*)d_in[6]; p.na_rpb = (const float*)d_in[7];
    p.diff_lambda = (const float*)d_in[8]; p.diff_subln_g = (const float*)d_in[9]; p.w_out = (const float*)d_in[10];
    p.ln1_g = (const float*)d_in[11]; p.ln1_b = (const float*)d_in[12]; p.w_gu = (const float*)d_in[13]; p.w_down = (const float*)d_in[14];
    p.ln2_g = (const float*)d_in[15]; p.ln2_b = (const float*)d_in[16];
    p.out = (float*)d_out; p.ws = (unsigned char*)d_ws;
    for (int i = 0; i < 32; ++i) p.invfC[i] = powf(10000.0f, -(float)i / 32.0f);
    for (int i = 0; i < 16; ++i) p.invfB[i] = powf(10000.0f, -(float)i / 16.0f);
    for (int l = 0; l < 2; ++l) p.lambda_init[l] = (float)(0.8 - 0.6 * exp(-0.3 * (double)l));
    if (hipMemsetAsync(d_ws, 0, 16384, stream) != hipSuccess) { fprintf(stderr, "kernel_launch: memset of the barrier words failed\n"); return; }
    void* args[] = {&p};
    hipError_t e = hipLaunchCooperativeKernel((const void*)fwd_megakernel, dim3(grid), dim3(512), args, LDS_BYTES, stream);
    if (e != hipSuccess) fprintf(stderr, "cooperative launch failed: %s (grid %d)\n", hipGetErrorString(e), grid);
}
```

```cpp
#include <hip/hip_runtime.h>
#include <hip/hip_cooperative_groups.h>
#include <cstdio>
#include <cstdint>
#include <cmath>
namespace cg = cooperative_groups;

#define DI __device__ __forceinline__
#define LAS __attribute__((address_space(3)))
typedef unsigned short bf16_t;
typedef short bf16x8 __attribute__((ext_vector_type(8)));
typedef short s16x4 __attribute__((ext_vector_type(4)));
typedef float f32x2 __attribute__((ext_vector_type(2)));
typedef float f32x4 __attribute__((ext_vector_type(4)));
typedef float f32x16 __attribute__((ext_vector_type(16)));
typedef unsigned u32x2 __attribute__((ext_vector_type(2)));
typedef unsigned u32x4 __attribute__((ext_vector_type(4)));
typedef __bf16 bf16x2_t __attribute__((ext_vector_type(2)));

#ifndef REP_B
#define REP_B 1
#endif
#ifndef REP_AC
#define REP_AC 1
#endif
constexpr float LOG2E = 1.4426950408889634f;
constexpr int DM = 1024, TH = 65536, NQKV = 3072, FF = 2816, NGU = 5632, NSEQ = 40;
constexpr int PQ = 3136;
constexpr float LN_EPS = 1e-5f;
constexpr float ALPHA = 1.4142135623730951f;

DI unsigned cvtpk(float lo, float hi) { f32x2 v = {lo, hi}; bf16x2_t b = __builtin_convertvector(v, bf16x2_t); return __builtin_bit_cast(unsigned, b); }
DI float bf_lo(unsigned u) { return __uint_as_float(u << 16); }
DI float bf_hi(unsigned u) { return __uint_as_float(u & 0xffff0000u); }
DI float fexp2(float x) { return __builtin_amdgcn_exp2f(x); }
template <class T> DI T* opqp(T* x) { asm volatile("" : "+s"(x)); return x; }
DI int lane_now() { int x; asm volatile("v_mbcnt_lo_u32_b32 %0, -1, 0\n\tv_mbcnt_hi_u32_b32 %0, -1, %0" : "=&v"(x)); return x; }
DI void lds_barrier() { asm volatile("s_waitcnt lgkmcnt(0)\n\ts_barrier" ::: "memory"); }
DI int opq(int x) { asm volatile("" : "+v"(x)); return x; }

namespace pg8 {
constexpr int BM = 256, BK = 64, HALF = 128, HTB = HALF * BK * 2, STAGE_BYTES = 8 * HTB, NXCD = 8, WGM = 8;
DI int lds_byte(int r, int c) { const int st = (r >> 4) * 2 + (c >> 5), rr = r & 15, cc = c & 31, ob = rr * 64 + cc * 2; return st * 1024 + (ob ^ (((ob >> 9) & 1) << 5)); }
DI void stage_rc(int b, int& R, int& C) { const int st = b / 1024, sb = b % 1024, swz = sb ^ (((sb >> 9) & 1) << 5); R = (st >> 1) * 16 + swz / 64; C = (st & 1) * 32 + (swz % 64) / 2; }
DI int perm32(int rho) { const int n = rho >> 4, i = rho & 15; return 8 * (i >> 2) + 4 * n + (i & 3); }
struct Unit { int pm, pn; };
struct Gemm { const bf16_t* A; const bf16_t* Bt; int M, N, K; };
struct StaticOrder {
    int nM, nN, nwg, G, c;
    DI void init(int M, int N, int G_, int c_) { nM = M / BM; nN = N / BM; nwg = nM * nN; G = G_; c = c_; }
    DI bool next(int i, Unit& u) const {
        const long L = (long)i * G + c; if (L >= nwg) return false;
        int wgid = (int)L; { const int q = nwg / NXCD, r = nwg % NXCD, xcd = wgid % NXCD, off = wgid / NXCD; wgid = (xcd < r ? xcd * (q + 1) : r * (q + 1) + (xcd - r) * q) + off; }
        const int nig = WGM * nN, gid = wgid / nig, fm = gid * WGM, gsz = (nM - fm) < WGM ? (nM - fm) : WGM;
        u.pm = fm + ((wgid % nig) % gsz); u.pn = (wgid % nig) / gsz; return true;
    }
};
template <class Epi>
DI void gemm_phase(LAS unsigned char* lds, const Gemm g, const StaticOrder& S, const Epi& E, int wid) {
    const int lane = lane_now(), tid = wid * 64 + lane, wr = wid >> 2, wc = wid & 3, fr = lane & 15, fq = lane >> 4;
    const int K = g.K, nt = K / BK;
    unsigned voffA[2], voffB[2];
#pragma unroll
    for (int i = 0; i < 2; ++i) { int R, C; stage_rc(tid * 16 + i * 8192, R, C); const int Rb = (R & ~31) + perm32(R & 31);
        voffA[i] = (unsigned)(R * K + C) * 2u; voffB[i] = (unsigned)(Rb * K + C) * 2u; }
    const size_t kstep = (size_t)(BK * 2);
    const size_t hstep = (size_t)HALF * K * 2;
    const size_t tstep = 2 * hstep;
    const unsigned ldsw = (unsigned)wid * 1024u;
    const int aoff = lds_byte(wr * 64 + fr, fq * 8), boff = lds_byte(wc * 32 + fr, fq * 8);
#define PG8_SA(b, h) (((b) * 2 + (h)) * HTB)
#define PG8_SB(b, h) ((4 + (b) * 2 + (h)) * HTB)
#define PG8_STAGE(bufoff, gbase, voff) do { _Pragma("unroll") for (int _i = 0; _i < 2; ++_i) \
        __builtin_amdgcn_global_load_lds((const unsigned*)((const char*)(gbase) + (voff)[_i]), (LAS unsigned*)(lds + (bufoff) + ldsw + _i * 8192), 16, 0, 0); } while (0)
#define PG8_LDA(dst, b, h) do { _Pragma("unroll") for (int m = 0; m < 4; ++m) _Pragma("unroll") for (int k = 0; k < 2; ++k) dst[m][k] = *(const LAS bf16x8*)(lds + PG8_SA(b, h) + aoff + m * 2048 + k * 1024); } while (0)
#define PG8_LDB(dst, b, h) do { _Pragma("unroll") for (int n = 0; n < 2; ++n) _Pragma("unroll") for (int k = 0; k < 2; ++k) dst[n][k] = *(const LAS bf16x8*)(lds + PG8_SB(b, h) + boff + n * 2048 + k * 1024); } while (0)
#define PG8_MMA(ai, bj, At, Bt) do { __builtin_amdgcn_s_setprio(1); _Pragma("unroll") for (int m = 0; m < 4; ++m) _Pragma("unroll") for (int n = 0; n < 2; ++n) _Pragma("unroll") for (int k = 0; k < 2; ++k) \
        acc[ai][bj][m][n] = __builtin_amdgcn_mfma_f32_16x16x32_bf16(Bt[n][k], At[m][k], acc[ai][bj][m][n], 0, 0, 0); __builtin_amdgcn_s_setprio(0); } while (0)
#define PG8_WAIT_V(n) asm volatile("s_waitcnt vmcnt(" #n ")" ::: "memory")
#define PG8_WAIT_L(n) asm volatile("s_waitcnt lgkmcnt(" #n ")" ::: "memory")
#define PG8_BAR __builtin_amdgcn_s_barrier()
#define PG8_SCHED __builtin_amdgcn_sched_barrier(0)
    Unit cur, nxt; int ui = 0;
    if (!S.next(0, cur)) return;
    f32x4 acc[2][2][4][2];
#pragma unroll
    for (int a = 0; a < 2; ++a)
#pragma unroll
        for (int b = 0; b < 2; ++b)
#pragma unroll
            for (int m = 0; m < 4; ++m)
#pragma unroll
                for (int n = 0; n < 2; ++n) acc[a][b][m][n] = (f32x4){0.f, 0.f, 0.f, 0.f};
    bf16x8 At[4][2], B0[2][2], B1[2][2];
    const char* cA = (const char*)g.A + (size_t)cur.pm * tstep; const char* cB = (const char*)g.Bt + (size_t)cur.pn * tstep;
    PG8_STAGE(PG8_SB(0, 0), cB, voffB); PG8_STAGE(PG8_SB(0, 1), cB + hstep, voffB); PG8_STAGE(PG8_SA(0, 0), cA, voffA); PG8_STAGE(PG8_SA(0, 1), cA + hstep, voffA);
    if (wr == 1) PG8_BAR;
    PG8_WAIT_V(2); PG8_BAR;
    PG8_STAGE(PG8_SB(1, 0), cB + kstep, voffB); PG8_STAGE(PG8_SA(1, 0), cA + kstep, voffA); PG8_STAGE(PG8_SB(1, 1), cB + hstep + kstep, voffB);
    PG8_WAIT_V(6); PG8_BAR;
    for (;;) {
        const bool has_next = S.next(ui + 1, nxt);
        const char* nA = has_next ? (const char*)g.A + (size_t)nxt.pm * tstep : cA; const char* nB = has_next ? (const char*)g.Bt + (size_t)nxt.pn * tstep : cB;
        for (int t = 0; t < nt; t += 2) {
            const bool last = (t == nt - 2);
            const char* a1 = cA + (size_t)(t + 1) * kstep;
            const char* a2 = last ? nA : cA + (size_t)(t + 2) * kstep; const char* b2 = last ? nB : cB + (size_t)(t + 2) * kstep;
            const char* a3 = a2 + kstep; const char* b3 = b2 + kstep;
            PG8_LDB(B0, 0, 0); PG8_LDB(B1, 0, 1); PG8_SCHED; PG8_LDA(At, 0, 0); PG8_STAGE(PG8_SA(1, 1), a1 + hstep, voffA);
            PG8_WAIT_V(8); PG8_WAIT_L(0); PG8_BAR; PG8_MMA(0, 0, At, B0); PG8_MMA(0, 1, At, B1); PG8_BAR; PG8_SCHED;
            PG8_LDA(At, 0, 1); PG8_STAGE(PG8_SB(0, 0), b2, voffB); PG8_STAGE(PG8_SB(0, 1), b2 + hstep, voffB); PG8_STAGE(PG8_SA(0, 0), a2, voffA);
            PG8_WAIT_V(8); PG8_WAIT_L(0); PG8_BAR; PG8_MMA(1, 0, At, B0); PG8_MMA(1, 1, At, B1); PG8_BAR; PG8_SCHED;
            PG8_LDB(B0, 1, 0); PG8_LDB(B1, 1, 1); PG8_SCHED; PG8_LDA(At, 1, 0); PG8_STAGE(PG8_SA(0, 1), a2 + hstep, voffA);
            PG8_WAIT_V(8); PG8_WAIT_L(0); PG8_BAR; PG8_MMA(0, 0, At, B0); PG8_MMA(0, 1, At, B1); PG8_BAR; PG8_SCHED;
            PG8_LDA(At, 1, 1); PG8_STAGE(PG8_SB(1, 0), b3, voffB); PG8_STAGE(PG8_SB(1, 1), b3 + hstep, voffB); PG8_STAGE(PG8_SA(1, 0), a3, voffA);
            PG8_WAIT_V(8); PG8_WAIT_L(0); PG8_BAR; PG8_MMA(1, 0, At, B0); PG8_MMA(1, 1, At, B1); PG8_BAR; PG8_SCHED;
        }
        if (wr == 0) PG8_BAR;
        E(acc, cur, wr, wc, fr, fq);
        if (!has_next) break;
#pragma unroll
        for (int a = 0; a < 2; ++a)
#pragma unroll
            for (int b = 0; b < 2; ++b)
#pragma unroll
                for (int m = 0; m < 4; ++m)
#pragma unroll
                    for (int n = 0; n < 2; ++n) acc[a][b][m][n] = (f32x4){0.f, 0.f, 0.f, 0.f};
        cur = nxt; cA = nA; cB = nB; ++ui;
        if (wr == 1) PG8_BAR;
    }
    PG8_WAIT_V(0);
    PG8_BAR;
#undef PG8_SA
#undef PG8_SB
#undef PG8_STAGE
#undef PG8_LDA
#undef PG8_LDB
#undef PG8_MMA
#undef PG8_WAIT_V
#undef PG8_WAIT_L
#undef PG8_BAR
#undef PG8_SCHED
}

struct EpiQKV {
    bf16_t* P; const float* cosC; const float* sinC; const float* cosB; const float* sinB; int Smask; LAS unsigned char* scr;
    DI void operator()(const f32x4 (&acc)[2][2][4][2], const Unit& u, int wr, int wc, int fr, int fq) const {
        const int pn = u.pn; const int row0 = u.pm * BM + wr * 64;
        const int kind = (pn == 3 || pn == 4) ? 1 : ((pn >= 6 && pn <= 9) ? 2 : 0);
        const float sc = (pn == 0 || pn == 6 || pn == 7) ? 0.125f * LOG2E : (pn == 3 ? 0.17677669529663687f * LOG2E : 1.f);
        LAS unsigned char* stg = scr + (wr * 4 + wc) * 2560;
        const int lane = fq * 16 + fr;
        const int off1 = (kind == 1) ? ((fq >> 1) * 32 + 8 * (fq & 1)) * 2 : (8 * fq) * 2;
        const int off2 = off1 + ((kind == 1) ? 32 : 64);
        const float* ct = (kind == 2) ? cosC : cosB; const float* st = (kind == 2) ? sinC : sinB;
        const int nf = (kind == 2) ? 32 : 16; const int i0 = (kind == 2) ? 8 * fq : 8 * (fq & 1);
#pragma unroll
        for (int ai = 0; ai < 2; ++ai)
#pragma unroll
            for (int m = 0; m < 4; ++m) { const int rbase = row0 + ai * HALF + m * 16;
                f32x4 a0 = acc[ai][0][m][0], a1 = acc[ai][0][m][1], b0 = acc[ai][1][m][0], b1 = acc[ai][1][m][1];
                if (kind != 0) {
                    const int pos = (rbase + fr) & Smask;
                    const f32x4 c0 = *(const f32x4*)(ct + (size_t)pos * nf + i0), c1 = *(const f32x4*)(ct + (size_t)pos * nf + i0 + 4);
                    const f32x4 s0 = *(const f32x4*)(st + (size_t)pos * nf + i0), s1 = *(const f32x4*)(st + (size_t)pos * nf + i0 + 4);
                    const f32x4 o10 = a0 * c0 - b0 * s0, o11 = a1 * c1 - b1 * s1, o20 = a0 * s0 + b0 * c0, o21 = a1 * s1 + b1 * c1;
                    a0 = o10; a1 = o11; b0 = o20; b1 = o21;
                }
                a0 = a0 * sc; a1 = a1 * sc; b0 = b0 * sc; b1 = b1 * sc;
                u32x4 w1, w2; w1.x = cvtpk(a0[0], a0[1]); w1.y = cvtpk(a0[2], a0[3]); w1.z = cvtpk(a1[0], a1[1]); w1.w = cvtpk(a1[2], a1[3]);
                w2.x = cvtpk(b0[0], b0[1]); w2.y = cvtpk(b0[2], b0[3]); w2.z = cvtpk(b1[0], b1[1]); w2.w = cvtpk(b1[2], b1[3]);
                *(LAS u32x4*)(stg + fr * 144 + off1) = w1; *(LAS u32x4*)(stg + fr * 144 + off2) = w2;
                asm volatile("s_waitcnt lgkmcnt(0)" ::: "memory");
                bf16_t* dst = P + (size_t)rbase * PQ + pn * 256 + wc * 64;
#pragma unroll
                for (int i = 0; i < 2; ++i) { const int pc = i * 64 + lane, row = pc >> 3, ch = pc & 7;
                    const u32x4 v = *(LAS const u32x4*)(stg + row * 144 + ch * 16);
                    *(u32x4*)(dst + (size_t)row * PQ + ch * 8) = v; }
            }
    }
};
template <bool RB, bool OB>
struct EpiRes {
    const void* res; void* out; const float* stats; const float* lng; const float* lnb; const float* gatebase; int Sshift;
    DI void operator()(const f32x4 (&acc)[2][2][4][2], const Unit& u, int wr, int wc, int fr, int fq) const {
        const int row0 = u.pm * BM + wr * 64 + fr; const int seq = (u.pm * BM) >> Sshift; const float* gate = gatebase + (size_t)seq * 6144;
        constexpr int NB = RB ? 4 : 2;
#pragma unroll
        for (int bj = 0; bj < 2; ++bj) { const int col = u.pn * BM + bj * HALF + wc * 32 + 8 * fq;
            const f32x4 g0 = *(const f32x4*)(gate + col), g1 = *(const f32x4*)(gate + col + 4);
            f32x4 lg0 = {1.f, 1.f, 1.f, 1.f}, lg1 = lg0, lb0 = {0.f, 0.f, 0.f, 0.f}, lb1 = lb0;
            if (stats) { lg0 = *(const f32x4*)(lng + col); lg1 = *(const f32x4*)(lng + col + 4); lb0 = *(const f32x4*)(lnb + col); lb1 = *(const f32x4*)(lnb + col + 4); }
#pragma unroll
            for (int b0 = 0; b0 < 8; b0 += NB) {
                u32x4 rw[NB]; f32x4 rf0[RB ? 1 : NB], rf1[RB ? 1 : NB]; f32x2 stv[NB];
#pragma unroll
                for (int q = 0; q < NB; ++q) { const int idx = b0 + q, ai = idx >> 2, m = idx & 3; const int row = row0 + ai * HALF + m * 16; const size_t off = (size_t)row * DM + col;
                    if (RB) rw[q] = *(const u32x4*)((const bf16_t*)res + off);
                    else { rf0[q] = __builtin_nontemporal_load((const f32x4*)((const float*)res + off)); rf1[q] = __builtin_nontemporal_load((const f32x4*)((const float*)res + off + 4)); }
                    stv[q] = stats ? *(const f32x2*)(stats + 2 * (size_t)row) : (f32x2){0.f, 1.f}; }
#pragma unroll
                for (int q = 0; q < NB; ++q) { const int idx = b0 + q, ai = idx >> 2, m = idx & 3; const int row = row0 + ai * HALF + m * 16; const size_t off = (size_t)row * DM + col;
                    f32x4 r0, r1;
                    if (RB) { const u32x4 w = rw[q]; r0 = (f32x4){bf_lo(w.x), bf_hi(w.x), bf_lo(w.y), bf_hi(w.y)}; r1 = (f32x4){bf_lo(w.z), bf_hi(w.z), bf_lo(w.w), bf_hi(w.w)}; }
                    else { r0 = rf0[q]; r1 = rf1[q]; }
                    if (stats) { const f32x2 st = stv[q]; r0 = (r0 - st.x) * st.y * lg0 + lb0; r1 = (r1 - st.x) * st.y * lg1 + lb1; }
                    const f32x4 y0 = r0 * ALPHA + g0 * acc[ai][bj][m][0], y1 = r1 * ALPHA + g1 * acc[ai][bj][m][1];
                    if (OB) { u32x4 w; w.x = cvtpk(y0[0], y0[1]); w.y = cvtpk(y0[2], y0[3]); w.z = cvtpk(y1[0], y1[1]); w.w = cvtpk(y1[2], y1[3]); *(u32x4*)((bf16_t*)out + off) = w; }
                    else { *(f32x4*)((float*)out + off) = y0; *(f32x4*)((float*)out + off + 4) = y1; } }
            } }
    }
};
struct EpiSwiGLU {
    bf16_t* O;
    DI void operator()(const f32x4 (&acc)[2][2][4][2], const Unit& u, int wr, int wc, int fr, int fq) const {
        const int row0 = u.pm * BM + wr * 64 + fr; const int col = u.pn * HALF + wc * 32 + 8 * fq;
#pragma unroll
        for (int ai = 0; ai < 2; ++ai)
#pragma unroll
            for (int m = 0; m < 4; ++m) { float a[8];
#pragma unroll
                for (int n = 0; n < 2; ++n)
#pragma unroll
                    for (int j = 0; j < 4; ++j) { const float gv = acc[ai][0][m][n][j], uv = acc[ai][1][m][n][j];
                        a[4 * n + j] = gv * __builtin_amdgcn_rcpf(1.f + fexp2(-gv * LOG2E)) * uv; }
                u32x4 w; w.x = cvtpk(a[0], a[1]); w.y = cvtpk(a[2], a[3]); w.z = cvtpk(a[4], a[5]); w.w = cvtpk(a[6], a[7]);
                *(u32x4*)(O + (size_t)(row0 + ai * HALF + m * 16) * FF + col) = w; }
    }
};
}

constexpr size_t MiB = 1u << 20;
constexpr size_t WS_MODP = 1 * MiB;
constexpr size_t WS_MODV = 17 * MiB;
constexpr size_t WS_ROPEC = 19 * MiB;
constexpr size_t WS_ROPEB = 21 * MiB;
constexpr size_t WS_STA = 22 * MiB;
constexpr size_t WS_STB = 23 * MiB;
constexpr size_t WS_W = 24 * MiB;
constexpr size_t W_IN = 0, W_OUT = 6 * MiB, W_GU = 8 * MiB, W_DOWN = 19 * MiB, W_LAYER = 25 * MiB;
constexpr size_t WS_XN = 80 * MiB;
constexpr size_t WS_PROJ = 208 * MiB;
constexpr size_t WS_PART = 600 * MiB;
constexpr size_t WS_ML = 728 * MiB;
constexpr size_t WS_YB = 736 * MiB;
constexpr size_t WS_END = 864 * MiB;
constexpr int LDS_BYTES = 131072 + 8 * 2560 + 16;
constexpr int LDS_SCR = 131072;

struct Params {
    const float* x[2]; const float* c[2];
    const float *w_ada, *b_ada, *w_in, *na_rpb, *diff_lambda, *diff_subln_g, *w_out, *ln1_g, *ln1_b, *w_gu, *w_down, *ln2_g, *ln2_b;
    float* out; unsigned char* ws;
    float invfC[32]; float invfB[16]; float lambda_init[2]; int pad[2];
};

DI int dest_row(int ptype, int ncol) {
    if (ptype == 0) {
        const int tile = ncol >> 8, a = ncol & 255;
        if (tile == 3 || tile == 4) { const int head = a >> 6, comp = (a >> 5) & 1, bj = (a >> 4) & 1, i = a & 15; return tile * 256 + bj * 128 + head * 32 + comp * 16 + i; }
        { const int head = a >> 6, bj = (a >> 5) & 1, i = a & 31; return tile * 256 + bj * 128 + head * 32 + i; }
    }
    if (ptype == 2) {
        if (ncol < FF) return (ncol >> 7) * 256 + (ncol & 127);
        const int a = ncol - FF; return (a >> 7) * 256 + 128 + (a & 127);
    }
    return ncol;
}
DI void transpose_item(const float* W, int K, int N, bf16_t* WT, int ptype, LAS float* scr, int item, int lane) {
    const int nblk = N / 32, kb = item / nblk, nb = item % nblk, k0 = 64 * kb, n0 = 32 * nb;
#pragma unroll 8
    for (int i = 0; i < 32; ++i) { const int kk = 2 * i + (lane >> 5); scr[kk * 33 + (lane & 31)] = W[(size_t)(k0 + kk) * N + n0 + (lane & 31)]; }
    asm volatile("s_waitcnt lgkmcnt(0)" ::: "memory");
    const int c = lane & 7;
#pragma unroll
    for (int j = 0; j < 4; ++j) { const int n = (lane >> 3) + 8 * j; const LAS float* s = scr + (8 * c) * 33 + n;
        u32x4 o; o.x = cvtpk(s[0 * 33], s[1 * 33]); o.y = cvtpk(s[2 * 33], s[3 * 33]); o.z = cvtpk(s[4 * 33], s[5 * 33]); o.w = cvtpk(s[6 * 33], s[7 * 33]);
        *(u32x4*)(WT + (size_t)dest_row(ptype, n0 + n) * K + k0 + 8 * c) = o; }
    asm volatile("s_waitcnt lgkmcnt(0)" ::: "memory");
}
DI float wave_sum(float v) {
#pragma unroll
    for (int o = 1; o < 64; o <<= 1) v += __shfl_xor(v, o);
    return v;
}
DI void sincos_d(float angf, float& s_out, float& c_out) {
    const double ang = (double)angf; const double kq = __builtin_rint(ang * 0.63661977236758134308);
    const double r = __builtin_fma(-kq, 1.57079632679489661923, ang) - kq * 6.123233995736766e-17; const double r2 = r * r;
    double sp = 1.0 / 6227020800.0; sp = sp * r2 - 1.0 / 39916800.0; sp = sp * r2 + 1.0 / 362880.0; sp = sp * r2 - 1.0 / 5040.0; sp = sp * r2 + 1.0 / 120.0; sp = sp * r2 - 1.0 / 6.0; sp = sp * r2 + 1.0; sp = sp * r;
    double cp = 1.0 / 479001600.0; cp = cp * r2 - 1.0 / 3628800.0; cp = cp * r2 + 1.0 / 40320.0; cp = cp * r2 - 1.0 / 720.0; cp = cp * r2 + 1.0 / 24.0; cp = cp * r2 - 0.5; cp = cp * r2 + 1.0;
    const int q = ((int)kq) & 3;
    const double sv = (q == 0) ? sp : (q == 1) ? cp : (q == 2) ? -sp : -cp;
    const double cv = (q == 0) ? cp : (q == 1) ? -sp : (q == 2) ? -cp : sp;
    s_out = (float)sv; c_out = (float)cv;
}

template <bool DO_LN, bool SB>
DI void ln_pass(const void* src, bf16_t* xn, float* stats, const float* lng, const float* lnb, const float* modbase, int which_sh, int Sshift, int gw, int lane) {
    auto ldrow = [&](int m, f32x4 (&d)[4]) {
        if (SB) { const u32x2* xr = (const u32x2*)((const bf16_t*)src + (size_t)m * DM) + lane;
#pragma unroll
            for (int j = 0; j < 4; ++j) { const u32x2 w = xr[64 * j]; d[j] = (f32x4){bf_lo(w.x), bf_hi(w.x), bf_lo(w.y), bf_hi(w.y)}; } }
        else { const f32x4* xr = (const f32x4*)((const float*)src + (size_t)m * DM) + lane;
#pragma unroll
            for (int j = 0; j < 4; ++j) d[j] = __builtin_nontemporal_load(xr + 64 * j); } };
    f32x4 nx[4];
    ldrow(gw, nx);
    for (int m = gw; m < TH; m += 2048) {
        f32x4 v[4];
#pragma unroll
        for (int j = 0; j < 4; ++j) v[j] = nx[j];
        if (m + 2048 < TH) ldrow(m + 2048, nx);
        const int seq = m >> Sshift; const float* sh = modbase + (size_t)seq * 6144 + which_sh * 1024; const float* scp = sh + 1024;
        f32x4 S4[4], H4[4], G4[4], B4[4];
#pragma unroll
        for (int j = 0; j < 4; ++j) { const int col = 4 * lane + 256 * j; S4[j] = *(const f32x4*)(scp + col); H4[j] = *(const f32x4*)(sh + col);
            if (DO_LN) { G4[j] = *(const f32x4*)(lng + col); B4[j] = *(const f32x4*)(lnb + col); } }
        __builtin_amdgcn_sched_barrier(0);
        float mean = 0.f, rstd = 1.f;
        if (DO_LN) {
            float s = 0.f;
#pragma unroll
            for (int j = 0; j < 4; ++j) s += (v[j].x + v[j].y) + (v[j].z + v[j].w);
            mean = wave_sum(s) * (1.f / DM); float s2 = 0.f;
#pragma unroll
            for (int j = 0; j < 4; ++j) { const f32x4 d = v[j] - mean; s2 += (d.x * d.x + d.y * d.y) + (d.z * d.z + d.w * d.w); }
            rstd = 1.0f / sqrtf(wave_sum(s2) * (1.f / DM) + LN_EPS);
            if (lane == 0) { stats[2 * (size_t)m] = mean; stats[2 * (size_t)m + 1] = rstd; }
        }
#pragma unroll
        for (int j = 0; j < 4; ++j) { const int col = 4 * lane + 256 * j; f32x4 xv = v[j];
            if (DO_LN) xv = (xv - mean) * rstd * G4[j] + B4[j];
            const f32x4 hv = xv * (S4[j] + 1.0f) + H4[j];
            u32x2 w; w.x = cvtpk(hv.x, hv.y); w.y = cvtpk(hv.z, hv.w);
            *(u32x2*)(xn + (size_t)m * DM + col) = w; }
    }
}
DI void final_ln(float* io, const float* lng, const float* lnb, int gw, int lane) {
    f32x4 nx[4];
    { const f32x4* xr0 = (const f32x4*)(io + (size_t)gw * DM) + lane;
#pragma unroll
      for (int j = 0; j < 4; ++j) nx[j] = xr0[64 * j]; }
    for (int m = gw; m < TH; m += 2048) {
        f32x4* xr = (f32x4*)(io + (size_t)m * DM) + lane;
        f32x4 v[4];
#pragma unroll
        for (int j = 0; j < 4; ++j) v[j] = nx[j];
        if (m + 2048 < TH) { const f32x4* xn_ = (const f32x4*)(io + (size_t)(m + 2048) * DM) + lane;
#pragma unroll
            for (int j = 0; j < 4; ++j) nx[j] = xn_[64 * j]; }
        float s = 0.f;
#pragma unroll
        for (int j = 0; j < 4; ++j) s += (v[j].x + v[j].y) + (v[j].z + v[j].w);
        const float mean = wave_sum(s) * (1.f / DM); float s2 = 0.f;
#pragma unroll
        for (int j = 0; j < 4; ++j) { const f32x4 d = v[j] - mean; s2 += (d.x * d.x + d.y * d.y) + (d.z * d.z + d.w * d.w); }
        const float rstd = 1.0f / sqrtf(wave_sum(s2) * (1.f / DM) + LN_EPS);
#pragma unroll
        for (int j = 0; j < 4; ++j) { const int col = 4 * lane + 256 * j; const f32x4 g4 = *(const f32x4*)(lng + col), b4 = *(const f32x4*)(lnb + col);
            __builtin_nontemporal_store((v[j] - mean) * rstd * g4 + b4, xr + 64 * j); }
    }
}

DI int crow(int r, int hi) { return (r & 3) + 8 * (r >> 2) + 4 * hi; }
DI int vbyte(int key, int chunk) { return (chunk >> 2) * 4096 + (key >> 4) * 1024 + (key & 15) * 64 + (chunk & 3) * 16; }
DI int kbyte(int key, int chunk) { return chunk * 1024 + (key >> 4) * 256 + (((key + 2 * chunk) & 15) << 4); }
DI float max3f(float a, float b, float c) { float r; asm("v_max3_f32 %0, %1, %2, %3" : "=v"(r) : "v"(a), "v"(b), "v"(c)); return r; }
DI float max2f(float a, float b) { float r; asm("v_max_f32_e32 %0, %1, %2" : "=v"(r) : "v"(a), "v"(b)); return r; }
DI float rowmax32(const f32x16& p0, const f32x16& p1) {
    float a = max3f(p0[0], p0[1], p1[0]), b = max3f(p0[2], p0[3], p1[1]); a = max3f(a, p1[2], p1[3]);
#pragma unroll
    for (int r = 4; r < 16; r += 4) { a = max3f(a, p0[r], p0[r + 1]); b = max3f(b, p0[r + 2], p0[r + 3]); a = max3f(a, p1[r], p1[r + 1]); b = max3f(b, p1[r + 2], p1[r + 3]); }
    return max2f(a, b);
}
DI float xhalf_max(float v) { auto rr = __builtin_amdgcn_permlane32_swap(__float_as_uint(v), __float_as_uint(v), false, false); return max2f(__uint_as_float(rr[0]), __uint_as_float(rr[1])); }
DI float xhalf_sum(float v) { auto rr = __builtin_amdgcn_permlane32_swap(__float_as_uint(v), __float_as_uint(v), false, false); return __uint_as_float(rr[0]) + __uint_as_float(rr[1]); }
typedef short v4i16_t __attribute__((ext_vector_type(4)));
DI s16x4 vtr(LAS const unsigned char* p) { return __builtin_bit_cast(s16x4, __builtin_amdgcn_ds_read_tr16_b64_v4i16((LAS v4i16_t*)p)); }

template <int ND0, int D0OFF>
DI void qk64(f32x16& p0, f32x16& p1, LAS const unsigned char* kslot, const bf16x8* qr, int r32, int hi) {
    bf16x8 kf[2 * ND0];
#pragma unroll
    for (int d0 = 0; d0 < ND0; ++d0) {
        LAS const unsigned char* kp = kslot + kbyte(r32, 2 * (D0OFF + d0) + hi);
        kf[2 * d0] = *(LAS const bf16x8*)kp; kf[2 * d0 + 1] = *(LAS const bf16x8*)(kp + 512);
    }
    __builtin_amdgcn_sched_barrier(0);
    f32x16 a, b;
#pragma unroll
    for (int i = 0; i < 16; ++i) { a[i] = 0.f; b[i] = 0.f; }
#pragma unroll
    for (int d0 = 0; d0 < ND0; ++d0) {
        a = __builtin_amdgcn_mfma_f32_32x32x16_bf16(kf[2 * d0], qr[D0OFF + d0], a, 0, 0, 0);
        b = __builtin_amdgcn_mfma_f32_32x32x16_bf16(kf[2 * d0 + 1], qr[D0OFF + d0], b, 0, 0, 0);
    }
    p0 = a; p1 = b;
}
DI void softmax_pv(f32x16& p0, f32x16& p1, float& m, float& l, f32x16& o0, f32x16& o1, LAS const unsigned char* vslot, int lane, int hi) {
    LAS const unsigned char* vp = vslot + ((lane >> 4) & 1) * 32 + (lane & 3) * 8 + (4 * hi + ((lane & 15) >> 2)) * 64;
    s16x4 vlo0[4], vhi0[4], vlo1[4], vhi1[4];
#pragma unroll
    for (int ks = 0; ks < 4; ++ks) { vlo0[ks] = vtr(vp + ks * 1024); vhi0[ks] = vtr(vp + ks * 1024 + 512); vlo1[ks] = vtr(vp + 4096 + ks * 1024); vhi1[ks] = vtr(vp + 4096 + ks * 1024 + 512); }
    __builtin_amdgcn_sched_barrier(0);
    const float mx = xhalf_max(rowmax32(p0, p1));
    const float mn = max2f(m, mx); const float f = fexp2(m - mn); m = mn;
    float s = 0.f;
#pragma unroll
    for (int r = 0; r < 16; ++r) { p0[r] = fexp2(p0[r] - mn); p1[r] = fexp2(p1[r] - mn); s += p0[r] + p1[r]; }
    s = xhalf_sum(s);
    l = l * f + s;
#pragma unroll
    for (int r = 0; r < 16; ++r) { o0[r] *= f; o1[r] *= f; }
    u32x4 pw[4];
    pw[0] = (u32x4){cvtpk(p0[0], p0[1]), cvtpk(p0[2], p0[3]), cvtpk(p0[4], p0[5]), cvtpk(p0[6], p0[7])};
    pw[1] = (u32x4){cvtpk(p0[8], p0[9]), cvtpk(p0[10], p0[11]), cvtpk(p0[12], p0[13]), cvtpk(p0[14], p0[15])};
    pw[2] = (u32x4){cvtpk(p1[0], p1[1]), cvtpk(p1[2], p1[3]), cvtpk(p1[4], p1[5]), cvtpk(p1[6], p1[7])};
    pw[3] = (u32x4){cvtpk(p1[8], p1[9]), cvtpk(p1[10], p1[11]), cvtpk(p1[12], p1[13]), cvtpk(p1[14], p1[15])};
#pragma unroll
    for (int ks = 0; ks < 4; ++ks) {
        const bf16x8 v0 = (bf16x8){vlo0[ks][0], vlo0[ks][1], vlo0[ks][2], vlo0[ks][3], vhi0[ks][0], vhi0[ks][1], vhi0[ks][2], vhi0[ks][3]};
        const bf16x8 v1 = (bf16x8){vlo1[ks][0], vlo1[ks][1], vlo1[ks][2], vlo1[ks][3], vhi1[ks][0], vhi1[ks][1], vhi1[ks][2], vhi1[ks][3]};
        const bf16x8 pf = __builtin_bit_cast(bf16x8, pw[ks]);
        o0 = __builtin_amdgcn_mfma_f32_32x32x16_bf16(v0, pf, o0, 0, 0, 0);
        o1 = __builtin_amdgcn_mfma_f32_32x32x16_bf16(v1, pf, o1, 0, 0, 0);
    }
}
DI f32x16 zero16() { f32x16 z;
#pragma unroll
    for (int i = 0; i < 16; ++i) z[i] = 0.f;
    return z; }
DI void store_oT(bf16_t* dst_row  , const f32x16& o0, const f32x16& o1, int hi) {
#pragma unroll
    for (int g = 0; g < 4; ++g) {
        u32x2 w0; w0.x = cvtpk(o0[4 * g], o0[4 * g + 1]); w0.y = cvtpk(o0[4 * g + 2], o0[4 * g + 3]);
        u32x2 w1; w1.x = cvtpk(o1[4 * g], o1[4 * g + 1]); w1.y = cvtpk(o1[4 * g + 2], o1[4 * g + 3]);
        *(u32x2*)(dst_row + 8 * g + 4 * hi) = w0; *(u32x2*)(dst_row + 32 + 8 * g + 4 * hi) = w1;
    }
}

constexpr int STG_ROW = 144, STG_BYTES = 5120, STG_OFF = 65536, STG_SC = 4608;
DI void stage_oT(LAS unsigned char* stg, const f32x16& o0, const f32x16& o1, int r32, int hi) {
#pragma unroll
    for (int g = 0; g < 4; ++g) {
        u32x2 w0; w0.x = cvtpk(o0[4 * g], o0[4 * g + 1]); w0.y = cvtpk(o0[4 * g + 2], o0[4 * g + 3]);
        u32x2 w1; w1.x = cvtpk(o1[4 * g], o1[4 * g + 1]); w1.y = cvtpk(o1[4 * g + 2], o1[4 * g + 3]);
        *(LAS u32x2*)(stg + r32 * STG_ROW + (8 * g + 4 * hi) * 2) = w0; *(LAS u32x2*)(stg + r32 * STG_ROW + 64 + (8 * g + 4 * hi) * 2) = w1;
    }
}
DI void flush_rows(LAS const unsigned char* stg, bf16_t* dst0, size_t row_stride, int lane) {
    asm volatile("s_waitcnt lgkmcnt(0)" ::: "memory");
#pragma unroll
    for (int i = 0; i < 4; ++i) { const int pc = i * 64 + lane, row = pc >> 3, ch = pc & 7;
        const u32x4 v = *(LAS const u32x4*)(stg + row * STG_ROW + ch * 16);
        *(u32x4*)(dst0 + (size_t)row * row_stride + ch * 8) = v; }
}

DI void attn_na_unit(int ua, int S, int layer, const bf16_t* PROJ, bf16_t* O, const float* rpb, LAS unsigned char* wl, LAS float* bias, int lane) {
    const int r32 = lane & 31, hi = lane >> 5;
    const int R = S >> 6;
    const int half_c = ua & 1; const int t1 = ua >> 1; const int r = t1 % R; const int t2 = t1 / R; const int head = t2 & 3; const int seq = t2 >> 2;
    const size_t seqrow = (size_t)seq * S;
    const int c = 32 * half_c + r32; const int cs = min(max(c - 8, 0), 48); const int rs = min(max(r - 4, 0), R - 8);
    const bf16_t* Qp = PROJ + (seqrow + (size_t)r * 64 + c) * PQ + head * 64;
    bf16x8 qr[4];
#pragma unroll
    for (int d0 = 0; d0 < 4; ++d0) qr[d0] = *(const bf16x8*)(Qp + 16 * d0 + 8 * hi);
    for (int i = lane; i < 465; i += 64) bias[i] = rpb[(size_t)(layer * 4 + head) * 465 + i] * LOG2E;
    const bf16_t* Kb = PROJ + seqrow * PQ + 256 + head * 64; const bf16_t* Vb = PROJ + seqrow * PQ + 512 + head * 64;
    float m = -1e30f, l = 0.f; f32x16 o0 = zero16(), o1 = zero16();
    u32x4 kreg[8], vreg[8];
    {   const size_t tb = (size_t)rs * 64;
#pragma unroll
        for (int i = 0; i < 8; ++i) { kreg[i] = *(const u32x4*)(Kb + (tb + 8 * i + (lane >> 3)) * PQ + 8 * (lane & 7));
            vreg[i] = *(const u32x4*)(Vb + (tb + 16 * (i & 3) + (lane >> 2)) * PQ + 32 * (i >> 2) + 8 * (lane & 3)); } }
    for (int j = 0; j < 8; ++j) {
        const int kr = rs + j;
#pragma unroll
        for (int i = 0; i < 8; ++i) { *(LAS u32x4*)(wl + kbyte(8 * i + (lane >> 3), lane & 7)) = kreg[i]; *(LAS u32x4*)(wl + 8192 + i * 1024 + lane * 16) = vreg[i]; }
        asm volatile("s_waitcnt lgkmcnt(0)" ::: "memory");
        if (j + 1 < 8) { const size_t tb = (size_t)(kr + 1) * 64;
#pragma unroll
            for (int i = 0; i < 8; ++i) { kreg[i] = *(const u32x4*)(Kb + (tb + 8 * i + (lane >> 3)) * PQ + 8 * (lane & 7));
                vreg[i] = *(const u32x4*)(Vb + (tb + 16 * (i & 3) + (lane >> 2)) * PQ + 32 * (i >> 2) + 8 * (lane & 3)); } }
        f32x16 p0, p1;
        qk64<4, 0>(p0, p1, wl, qr, r32, hi);
        const int dr = kr - r + 7; LAS const float* brow = bias + dr * 31;
#pragma unroll
        for (int rr = 0; rr < 16; ++rr) {
            const int k0 = crow(rr, hi), k1 = k0 + 32;
            const int i0 = min(max(k0 - c + 15, 0), 30), i1 = min(max(k1 - c + 15, 0), 30);
            const float b0 = brow[i0], b1 = brow[i1];
            p0[rr] = (k0 >= cs && k0 < cs + 16) ? p0[rr] + b0 : -INFINITY;
            p1[rr] = (k1 >= cs && k1 < cs + 16) ? p1[rr] + b1 : -INFINITY;
        }
        softmax_pv(p0, p1, m, l, o0, o1, wl + 8192, lane, hi);
        asm volatile("s_waitcnt lgkmcnt(0)" ::: "memory");
    }
    const float inv = 1.0f / l;
#pragma unroll
    for (int i = 0; i < 16; ++i) { o0[i] *= inv; o1[i] *= inv; }
    store_oT(O + (seqrow + (size_t)r * 64 + c) * DM + head * 64, o0, o1, hi);
}

template <int MODE>
DI void attn_dil_unit(int uc, int S, int dsh  , int slot, const bf16_t* PROJ, bf16_t* O, bf16_t* PART, float* ML, LAS unsigned char* wl, int lane) {
    const int r32 = lane & 31, hi = lane >> 5;
    const int upsh = S >> 5;
    const int j = uc % upsh; const int t2 = uc / upsh; const int head = t2 & 7; const int seq = t2 >> 3;
    const int L = S >> dsh; const int bps = L >> 5; const int rho = j / bps; const int a = j % bps;
    const size_t seqrow = (size_t)seq * S;
    const int nq = 32 * a + r32; const size_t qrow = seqrow + ((size_t)nq << dsh) + rho;
    const bf16_t* Qp = PROJ + qrow * PQ + 1536 + head * 64;
    bf16x8 qr[4];
#pragma unroll
    for (int d0 = 0; d0 < 4; ++d0) qr[d0] = *(const bf16x8*)(Qp + 16 * d0 + 8 * hi);
    const bf16_t* Kb = PROJ + seqrow * PQ + 2048 + head * 64; const bf16_t* Vb = PROJ + seqrow * PQ + 2560 + head * 64;
    float m = -1e30f, l = 0.f; f32x16 o0 = zero16(), o1 = zero16();
    u32x4 kreg[8], vreg[8];
#define DIL_LOAD(n0_) do { \
        _Pragma("unroll") for (int i = 0; i < 8; ++i) { const int nk_ = min(max((n0_) + 8 * i + (lane >> 3), 0), L - 1); \
            kreg[i] = *(const u32x4*)(Kb + (((size_t)nk_ << dsh) + rho) * PQ + 8 * (lane & 7)); \
            const int nv_ = min(max((n0_) + 16 * (i & 3) + (lane >> 2), 0), L - 1); \
            vreg[i] = *(const u32x4*)(Vb + (((size_t)nv_ << dsh) + rho) * PQ + 32 * (i >> 2) + 8 * (lane & 3)); } } while (0)
    DIL_LOAD(32 * a - 64);
    for (int t = 0; t < 3; ++t) {
        const int n0 = 32 * a - 64 + 64 * t;
#pragma unroll
        for (int i = 0; i < 8; ++i) { *(LAS u32x4*)(wl + kbyte(8 * i + (lane >> 3), lane & 7)) = kreg[i]; *(LAS u32x4*)(wl + 8192 + i * 1024 + lane * 16) = vreg[i]; }
        asm volatile("s_waitcnt lgkmcnt(0)" ::: "memory");
        if (t + 1 < 3) DIL_LOAD(n0 + 64);
        f32x16 p0, p1;
        qk64<4, 0>(p0, p1, wl, qr, r32, hi);
#pragma unroll
        for (int rr = 0; rr < 16; ++rr) {
            const int k0 = n0 + crow(rr, hi), k1 = k0 + 32;
            const int d0 = nq - k0, d1 = nq - k1;
            p0[rr] = (d0 <= 64 && d0 >= -64 && k0 >= 0 && k0 < L) ? p0[rr] : -INFINITY;
            p1[rr] = (d1 <= 64 && d1 >= -64 && k1 >= 0 && k1 < L) ? p1[rr] : -INFINITY;
        }
        softmax_pv(p0, p1, m, l, o0, o1, wl + 8192, lane, hi);
        asm volatile("s_waitcnt lgkmcnt(0)" ::: "memory");
    }
#undef DIL_LOAD
    if (MODE == 0) {
        const float inv = 1.0f / l;
#pragma unroll
        for (int i = 0; i < 16; ++i) { o0[i] *= inv; o1[i] *= inv; }
        store_oT(PART + (((size_t)slot * TH + qrow) * 8 + head) * 64, o0, o1, hi);
        if (hi == 0) { f32x2 ml = {m, l}; *(f32x2*)(ML + (((size_t)slot * TH + qrow) * 8 + head) * 2) = ml; }
    } else {
        const f32x2 ml4 = *(const f32x2*)(ML + (((size_t)0 * TH + qrow) * 8 + head) * 2);
        const f32x2 ml16 = *(const f32x2*)(ML + (((size_t)1 * TH + qrow) * 8 + head) * 2);
        const float mall = fmaxf(m, fmaxf(ml4.x, ml16.x));
        const float w1 = fexp2(m - mall), w4 = fexp2(ml4.x - mall) * ml4.y, w16 = fexp2(ml16.x - mall) * ml16.y;
        const float inv = 1.0f / (w1 * l + w4 + w16);
        const bf16_t* P4 = PART + (((size_t)0 * TH + qrow) * 8 + head) * 64; const bf16_t* P16 = PART + (((size_t)1 * TH + qrow) * 8 + head) * 64;
#pragma unroll
        for (int g = 0; g < 4; ++g) {
            const u32x2 a0 = *(const u32x2*)(P4 + 8 * g + 4 * hi), a1 = *(const u32x2*)(P4 + 32 + 8 * g + 4 * hi);
            const u32x2 b0 = *(const u32x2*)(P16 + 8 * g + 4 * hi), b1 = *(const u32x2*)(P16 + 32 + 8 * g + 4 * hi);
            o0[4 * g + 0] = (w1 * o0[4 * g + 0] + w4 * bf_lo(a0.x) + w16 * bf_lo(b0.x)) * inv; o0[4 * g + 1] = (w1 * o0[4 * g + 1] + w4 * bf_hi(a0.x) + w16 * bf_hi(b0.x)) * inv;
            o0[4 * g + 2] = (w1 * o0[4 * g + 2] + w4 * bf_lo(a0.y) + w16 * bf_lo(b0.y)) * inv; o0[4 * g + 3] = (w1 * o0[4 * g + 3] + w4 * bf_hi(a0.y) + w16 * bf_hi(b0.y)) * inv;
            o1[4 * g + 0] = (w1 * o1[4 * g + 0] + w4 * bf_lo(a1.x) + w16 * bf_lo(b1.x)) * inv; o1[4 * g + 1] = (w1 * o1[4 * g + 1] + w4 * bf_hi(a1.x) + w16 * bf_hi(b1.x)) * inv;
            o1[4 * g + 2] = (w1 * o1[4 * g + 2] + w4 * bf_lo(a1.y) + w16 * bf_lo(b1.y)) * inv; o1[4 * g + 3] = (w1 * o1[4 * g + 3] + w4 * bf_hi(a1.y) + w16 * bf_hi(b1.y)) * inv;
        }
        store_oT(O + qrow * DM + 512 + head * 64, o0, o1, hi);
    }
}

#define WALK_LOADS(KR_, VR_, KROW_, VROW_) do { \
        _Pragma("unroll") for (int e = 0; e < 2; ++e) { const int i_ = 2 * w4 + e; \
            KR_[e] = *(const u32x4*)(Kb_ + (size_t)(KROW_(8 * i_ + (lane >> 3))) * PQ + 8 * (lane & 7)); \
            VR_[e] = *(const u32x4*)(Vb_ + (size_t)(VROW_(8 * i_ + (lane >> 3))) * PQ + 8 * (lane & 7)); } } while (0)
#define WALK_STORES(KR_, VR_, dst_) do { \
        _Pragma("unroll") for (int e = 0; e < 2; ++e) { const int i_ = 2 * w4 + e; \
            *(LAS u32x4*)((dst_) + kbyte(8 * i_ + (lane >> 3), lane & 7)) = KR_[e]; *(LAS u32x4*)((dst_) + 8192 + vbyte(8 * i_ + (lane >> 3), lane & 7)) = VR_[e]; } } while (0)

template <int MODE>
DI void walk_dil(int Ssh, int nseq, int dsh, int slot, const bf16_t* PROJ, bf16_t* O, bf16_t* PART, float* ML, LAS unsigned char* lds, int wid, int lane, int wgi) {
    constexpr int NW = 512; const int S = 1 << Ssh;
    const int r32 = lane & 31, hi = lane >> 5, g = wid >> 2, w4 = g ? 3 - (wid & 3) : (wid & 3);
    LAS unsigned char* wb = lds + g * 32768;
    const int L = S >> dsh, ush = Ssh - 7, bsh = Ssh - dsh - 7;
    const int F = ((nseq * 8) << ush) / NW * 4;
    u32x4 kA[2], vA[2], kB[2], vB[2]; bf16x8 qr[4], qn[4];
    float m = -1e30f, l = 0.f; f32x16 o0 = zero16(), o1 = zero16();
    int c_head = 0, c_rho = 0, c_A = 0; size_t c_seqrow = 0;
    f32x2 pml4 = {0.f, 0.f}, pml16 = {0.f, 0.f};
#define DIL_DECODE(u_, head_, rho_, A_, seqrow_) do { const int j_ = (u_) & ((1 << ush) - 1); const int t2_ = (u_) >> ush; head_ = t2_ & 7; seqrow_ = (size_t)(t2_ >> 3) << Ssh; rho_ = j_ >> bsh; A_ = j_ & ((1 << bsh) - 1); } while (0)
#define DIL_TILE_LOAD(KR_, VR_, f_) do { const int u_ = wgi + ((f_) >> 2) * NW; int h_, rho_, A_; size_t sr_; DIL_DECODE(u_, h_, rho_, A_, sr_); \
        const bf16_t* Kb_ = PROJ + sr_ * PQ + 2048 + h_ * 64; const bf16_t* Vb_ = PROJ + sr_ * PQ + 2560 + h_ * 64; const int n0_ = 128 * A_ - 64 + 64 * ((f_) & 3); \
        auto rowf = [&](int k_) { return (((size_t)min(max(n0_ + k_, 0), L - 1)) << dsh) + rho_; }; \
        WALK_LOADS(KR_, VR_, rowf, rowf); } while (0)
#define DIL_Q_LOAD(dst_, u_) do { int h_, rho_, A_; size_t sr_; DIL_DECODE(u_, h_, rho_, A_, sr_); \
        const bf16_t* Qp_ = PROJ + (sr_ + (((size_t)(128 * A_ + 32 * w4 + r32)) << dsh) + rho_) * PQ + 1536 + h_ * 64; \
        _Pragma("unroll") for (int d0 = 0; d0 < 4; ++d0) dst_[d0] = *(const bf16x8*)(Qp_ + 16 * d0 + 8 * hi); } while (0)
    DIL_TILE_LOAD(kA, vA, 0); DIL_Q_LOAD(qr, wgi);
    WALK_STORES(kA, vA, wb);
    DIL_TILE_LOAD(kB, vB, 1);
    lds_barrier();
    auto body = [&](const int f, LAS unsigned char* cur) {
        const int s = f & 3;
        if (s == 0) { DIL_DECODE(wgi + (f >> 2) * NW, c_head, c_rho, c_A, c_seqrow); m = -1e30f; l = 0.f; o0 = zero16(); o1 = zero16();
            if (MODE == 1) { const size_t qrow_ = c_seqrow + (size_t)(128 * c_A + 32 * w4 + r32);
                pml4 = *(const f32x2*)(ML + (((size_t)0 * TH + qrow_) * 8 + c_head) * 2); pml16 = *(const f32x2*)(ML + (((size_t)1 * TH + qrow_) * 8 + c_head) * 2); } }
        if (s == 1 && f + 3 < F) DIL_Q_LOAD(qn, wgi + ((f + 3) >> 2) * NW);
        const int nq = 128 * c_A + 32 * w4 + r32;
        if (s >= (w4 >> 1) && s <= (w4 >> 1) + 2) {
            const int n0 = 128 * c_A - 64 + 64 * s;
            f32x16 p0, p1;
            qk64<4, 0>(p0, p1, cur, qr, r32, hi);
            const int nq0 = 128 * c_A + 32 * w4;
            const bool allvalid = (n0 >= 0) && (n0 + 63 < L) && (nq0 + 31 - n0 <= 64) && (n0 + 63 - nq0 <= 64);
            if (!allvalid) {
                const int lo = max(nq - 64, 0), hb = min(nq + 64, L - 1);
                const unsigned ub = (unsigned)(n0 + 4 * hi - lo), wv = (unsigned)(hb - lo);
#pragma unroll
                for (int rr = 0; rr < 16; ++rr) {
                    const unsigned c0 = (unsigned)((rr & 3) + 8 * (rr >> 2));
                    p0[rr] = (ub + c0 <= wv) ? p0[rr] : -INFINITY;
                    p1[rr] = (ub + c0 + 32u <= wv) ? p1[rr] : -INFINITY;
                }
            }
            softmax_pv(p0, p1, m, l, o0, o1, cur + 8192, lane, hi);
        }
        if (s == 3) {
            const size_t qrow = c_seqrow + (((size_t)nq) << dsh) + c_rho; const int head = c_head;
            const size_t qrow0 = c_seqrow + (((size_t)(128 * c_A + 32 * w4)) << dsh) + c_rho;
            LAS unsigned char* stg = lds + STG_OFF + wid * STG_BYTES;
            if (MODE == 0) {
                const float inv = 1.0f / l;
#pragma unroll
                for (int i = 0; i < 16; ++i) { o0[i] *= inv; o1[i] *= inv; }
                stage_oT(stg, o0, o1, r32, hi);
                flush_rows(stg, PART + (((size_t)slot * TH + qrow0) * 8 + head) * 64, (size_t)512 << dsh, lane);
                if (hi == 0) { f32x2 ml = {m, l}; *(f32x2*)(ML + (((size_t)slot * TH + qrow) * 8 + head) * 2) = ml; }
            } else {
                const f32x2 ml4 = pml4, ml16 = pml16;
                const float mall = fmaxf(m, fmaxf(ml4.x, ml16.x));
                const float w1 = fexp2(m - mall), w4_ = fexp2(ml4.x - mall) * ml4.y, w16 = fexp2(ml16.x - mall) * ml16.y;
                const float inv = 1.0f / (w1 * l + w4_ + w16);
                const float s1 = w1 * inv;
#pragma unroll
                for (int i = 0; i < 16; ++i) { o0[i] *= s1; o1[i] *= s1; }
                stage_oT(stg, o0, o1, r32, hi);
                if (hi == 0) { f32x2 sc = {w4_ * inv, w16 * inv}; *(LAS f32x2*)(stg + STG_SC + r32 * 8) = sc; }
                asm volatile("s_waitcnt lgkmcnt(0)" ::: "memory");
                const bf16_t* P4 = PART + (((size_t)0 * TH + qrow0) * 8 + head) * 64; const bf16_t* P16 = PART + (((size_t)1 * TH + qrow0) * 8 + head) * 64;
                bf16_t* Od = O + qrow0 * DM + 512 + head * 64;
#pragma unroll
                for (int i = 0; i < 4; ++i) { const int pc = i * 64 + lane, row = pc >> 3, ch = pc & 7;
                    const u32x4 own = *(LAS const u32x4*)(stg + row * STG_ROW + ch * 16);
                    const f32x2 sc = *(LAS const f32x2*)(stg + STG_SC + row * 8);
                    const u32x4 a = *(const u32x4*)(P4 + (size_t)row * 512 + ch * 8), b = *(const u32x4*)(P16 + (size_t)row * 512 + ch * 8);
                    u32x4 r;
                    r.x = cvtpk(bf_lo(own.x) + sc.x * bf_lo(a.x) + sc.y * bf_lo(b.x), bf_hi(own.x) + sc.x * bf_hi(a.x) + sc.y * bf_hi(b.x));
                    r.y = cvtpk(bf_lo(own.y) + sc.x * bf_lo(a.y) + sc.y * bf_lo(b.y), bf_hi(own.y) + sc.x * bf_hi(a.y) + sc.y * bf_hi(b.y));
                    r.z = cvtpk(bf_lo(own.z) + sc.x * bf_lo(a.z) + sc.y * bf_lo(b.z), bf_hi(own.z) + sc.x * bf_hi(a.z) + sc.y * bf_hi(b.z));
                    r.w = cvtpk(bf_lo(own.w) + sc.x * bf_lo(a.w) + sc.y * bf_lo(b.w), bf_hi(own.w) + sc.x * bf_hi(a.w) + sc.y * bf_hi(b.w));
                    *(u32x4*)(Od + (size_t)row * DM + ch * 8) = r; }
            }
#pragma unroll
            for (int d0 = 0; d0 < 4; ++d0) qr[d0] = qn[d0];
        }
    };
    for (int f = 0; f < F; f += 2) {
        if (f + 2 < F) DIL_TILE_LOAD(kA, vA, f + 2);
        body(f, wb);
        WALK_STORES(kB, vB, wb + 16384);
        lds_barrier();
        if (f + 3 < F) DIL_TILE_LOAD(kB, vB, f + 3);
        body(f + 1, wb + 16384);
        if (f + 2 < F) WALK_STORES(kA, vA, wb);
        lds_barrier();
    }
#undef DIL_DECODE
#undef DIL_TILE_LOAD
#undef DIL_Q_LOAD
}

DI void walk_na(int Ssh, int nseq, int layer, const bf16_t* PROJ, bf16_t* O, const float* rpb, LAS unsigned char* lds, LAS float* bias, int wid, int lane, int wgi) {
    constexpr int NW = 512; const int S = 1 << Ssh;
    const int r32 = lane & 31, hi = lane >> 5, g = wid >> 2, w4 = g ? 3 - (wid & 3) : (wid & 3);
    LAS unsigned char* wb = lds + g * 32768;
    const int R = S >> 6, rsh = Ssh - 7;
    const int F = ((nseq * 4) << rsh) / NW * 9;
    u32x4 kA[2], vA[2], kB[2], vB[2]; bf16x8 qr[4], qn[4];
    float m = -1e30f, l = 0.f; f32x16 o0 = zero16(), o1 = zero16();
    int c_head = 0, c_r0 = 0, bias_head = -1; size_t c_seqrow = 0;
    const int half_c = w4 & 1; const int c = 32 * half_c + r32; const int cs = min(max(c - 8, 0), 48);
#define NA_DECODE(u_, head_, r0_, seqrow_) do { const int rp_ = (u_) & ((1 << rsh) - 1); const int t2_ = (u_) >> rsh; head_ = t2_ & 3; seqrow_ = (size_t)(t2_ >> 2) << Ssh; r0_ = 2 * rp_; } while (0)
#define NA_TILE_LOAD(KR_, VR_, f_) do { const int u_ = wgi + ((f_) / 9) * NW; int h_, r0_; size_t sr_; NA_DECODE(u_, h_, r0_, sr_); \
        const int kr_ = min(min(max(r0_ - 4, 0), R - 8) + (f_) % 9, R - 1); \
        const bf16_t* Kb_ = PROJ + (sr_ + (size_t)kr_ * 64) * PQ + 256 + h_ * 64; const bf16_t* Vb_ = PROJ + (sr_ + (size_t)kr_ * 64) * PQ + 512 + h_ * 64; \
        auto rowf = [&](int k_) { return k_; }; \
        WALK_LOADS(KR_, VR_, rowf, rowf); } while (0)
#define NA_Q_LOAD(dst_, u_) do { int h_, r0_; size_t sr_; NA_DECODE(u_, h_, r0_, sr_); \
        const bf16_t* Qp_ = PROJ + (sr_ + (size_t)(r0_ + (w4 >> 1)) * 64 + c) * PQ + h_ * 64; \
        _Pragma("unroll") for (int d0 = 0; d0 < 4; ++d0) dst_[d0] = *(const bf16x8*)(Qp_ + 16 * d0 + 8 * hi); } while (0)
    NA_TILE_LOAD(kA, vA, 0); NA_Q_LOAD(qr, wgi);
    WALK_STORES(kA, vA, wb);
    NA_TILE_LOAD(kB, vB, 1);
    lds_barrier();
    auto body = [&](const int f, LAS unsigned char* cur) {
        const int s = f % 9;
        if (s == 0) { NA_DECODE(wgi + (f / 9) * NW, c_head, c_r0, c_seqrow); m = -1e30f; l = 0.f; o0 = zero16(); o1 = zero16();
            if (c_head != bias_head) {
                for (int i = lane; i < 465; i += 64) bias[i] = rpb[(size_t)(layer * 4 + c_head) * 465 + i] * LOG2E;
                asm volatile("s_waitcnt lgkmcnt(0)" ::: "memory"); bias_head = c_head; } }
        if (s == 5 && f + 4 < F) NA_Q_LOAD(qn, wgi + ((f + 4) / 9) * NW);
        const int r = c_r0 + (w4 >> 1); const int rs = min(max(r - 4, 0), R - 8); const int kr = min(max(c_r0 - 4, 0), R - 8) + s;
        if (kr >= rs && kr < rs + 8) {
            f32x16 p0, p1;
            qk64<4, 0>(p0, p1, cur, qr, r32, hi);
            const int dr = kr - r + 7;
            LAS const float* bp = bias + dr * 31 + (15 - c + 4 * hi);
            const unsigned ub = (unsigned)(4 * hi - cs);
#pragma unroll
            for (int rr = 0; rr < 16; ++rr) {
                const int c0 = (rr & 3) + 8 * (rr >> 2);
                const float b0 = bp[c0], b1 = bp[c0 + 32];
                p0[rr] = (ub + (unsigned)c0 < 16u) ? p0[rr] + b0 : -INFINITY;
                p1[rr] = (ub + (unsigned)c0 + 32u < 16u) ? p1[rr] + b1 : -INFINITY;
            }
            softmax_pv(p0, p1, m, l, o0, o1, cur + 8192, lane, hi);
        }
        if (s == 8) {
            const float inv = 1.0f / l;
#pragma unroll
            for (int i = 0; i < 16; ++i) { o0[i] *= inv; o1[i] *= inv; }
            LAS unsigned char* stg = lds + STG_OFF + wid * STG_BYTES;
            stage_oT(stg, o0, o1, r32, hi);
            flush_rows(stg, O + (c_seqrow + (size_t)r * 64 + 32 * half_c) * DM + c_head * 64, (size_t)DM, lane);
#pragma unroll
            for (int d0 = 0; d0 < 4; ++d0) qr[d0] = qn[d0];
        }
    };
    for (int f = 0; f < F; f += 2) {
        if (f + 2 < F) NA_TILE_LOAD(kA, vA, f + 2);
        body(f, wb);
        WALK_STORES(kB, vB, wb + 16384);
        lds_barrier();
        if (f + 3 < F) NA_TILE_LOAD(kB, vB, f + 3);
        body(f + 1, wb + 16384);
        if (f + 2 < F) WALK_STORES(kA, vA, wb);
        lds_barrier();
    }
#undef NA_DECODE
#undef NA_TILE_LOAD
#undef NA_Q_LOAD
}

template <int D0OFF>
DI void qk64n(f32x16& p0, f32x16& p1, LAS const unsigned char* kslot, const bf16x8* qr, const f32x16& neg, int r32, int hi) {
    LAS const unsigned char* kpa = kslot + kbyte(r32, 2 * D0OFF + hi); LAS const unsigned char* kpb = kslot + kbyte(r32, 2 * D0OFF + 2 + hi);
    const bf16x8 k00 = *(LAS const bf16x8*)kpa, k01 = *(LAS const bf16x8*)(kpa + 512), k10 = *(LAS const bf16x8*)kpb, k11 = *(LAS const bf16x8*)(kpb + 512);
    f32x16 a = __builtin_amdgcn_mfma_f32_32x32x16_bf16(k00, qr[D0OFF], neg, 0, 0, 0);
    f32x16 b = __builtin_amdgcn_mfma_f32_32x32x16_bf16(k01, qr[D0OFF], neg, 0, 0, 0);
    p0 = __builtin_amdgcn_mfma_f32_32x32x16_bf16(k10, qr[D0OFF + 1], a, 0, 0, 0);
    p1 = __builtin_amdgcn_mfma_f32_32x32x16_bf16(k11, qr[D0OFF + 1], b, 0, 0, 0);
}
DI void softmax_lazy(f32x16& p0, f32x16& p1, float& m, float& l, f32x16& o0, f32x16& o1, u32x4 (&pw)[4], bool first) {
    const float mx = xhalf_max(rowmax32(p0, p1));
    if (first || __any(mx > m + 8.0f)) {
        const float mn = first ? mx : max2f(m, mx);
        const float f = fexp2(m - mn); m = mn; l *= f;
#pragma unroll
        for (int r = 0; r < 16; ++r) { o0[r] *= f; o1[r] *= f; }
    }
    float s0 = 0.f, s1 = 0.f;
#pragma unroll
    for (int r = 0; r < 16; ++r) { p0[r] = fexp2(p0[r] - m); p1[r] = fexp2(p1[r] - m); s0 += p0[r]; s1 += p1[r]; }
    l += xhalf_sum(s0 + s1);
    pw[0] = (u32x4){cvtpk(p0[0], p0[1]), cvtpk(p0[2], p0[3]), cvtpk(p0[4], p0[5]), cvtpk(p0[6], p0[7])};
    pw[1] = (u32x4){cvtpk(p0[8], p0[9]), cvtpk(p0[10], p0[11]), cvtpk(p0[12], p0[13]), cvtpk(p0[14], p0[15])};
    pw[2] = (u32x4){cvtpk(p1[0], p1[1]), cvtpk(p1[2], p1[3]), cvtpk(p1[4], p1[5]), cvtpk(p1[6], p1[7])};
    pw[3] = (u32x4){cvtpk(p1[8], p1[9]), cvtpk(p1[10], p1[11]), cvtpk(p1[12], p1[13]), cvtpk(p1[14], p1[15])};
}
DI void attn_diff_unit(int ub, int Ssh, float lam, float post, const float* subg, const bf16_t* PROJ, bf16_t* O, LAS unsigned char* lds, int wid, int lane) {
    const int r32 = lane & 31, hi = lane >> 5;
    const int S = 1 << Ssh; const int qb = ub & ((1 << (Ssh - 8)) - 1); const int t2 = ub >> (Ssh - 8); const int head = t2 & 3; const int seq = t2 >> 2;
    const size_t seqrow = (size_t)seq << Ssh;
    const size_t qrow = seqrow + (size_t)qb * 256 + wid * 32 + r32;
    const bf16_t* Qp = PROJ + qrow * PQ + 768 + head * 64;
    bf16x8 qr[4];
#pragma unroll
    for (int d0 = 0; d0 < 4; ++d0) qr[d0] = *(const bf16x8*)(Qp + 16 * d0 + 8 * hi);
    const bf16_t* Kb = PROJ + seqrow * PQ + 1024 + head * 64; const bf16_t* Vb = PROJ + seqrow * PQ + 1280 + head * 64;
    const bf16_t* ksrc = Kb + (size_t)(8 * wid + (lane >> 3)) * PQ + 8 * (lane & 7);
    const bf16_t* vsrc = Vb + (size_t)(8 * wid + (lane >> 3)) * PQ + 8 * (lane & 7);
    const int kdst = kbyte(8 * wid + (lane >> 3), lane & 7), vdst = 8192 + vbyte(8 * wid + (lane >> 3), lane & 7);
    const int NT = S >> 6;
    float mA = 0.f, mB = 0.f, lA = 0.f, lB = 0.f; f32x16 a0 = zero16(), a1 = zero16(), b0 = zero16(), b1 = zero16();
    u32x4 kA = *(const u32x4*)ksrc, vA = *(const u32x4*)vsrc;
    *(LAS u32x4*)(lds + kdst) = kA; *(LAS u32x4*)(lds + vdst) = vA;
    __syncthreads();
    const int vlane = ((lane >> 4) & 1) * 32 + (lane & 3) * 8 + (4 * hi + ((lane & 15) >> 2)) * 64;
    auto tile = [&](const int t, LAS unsigned char* cur) {
        f32x16 pa0, pa1, pb0, pb1; u32x4 pwA[4], pwB[4];
        qk64<2, 0>(pa0, pa1, cur, qr, r32, hi);
        qk64<2, 2>(pb0, pb1, cur, qr, r32, hi);
        const float mxA = xhalf_max(rowmax32(pa0, pa1)), mxB = xhalf_max(rowmax32(pb0, pb1));
        if (t == 0 || __any(mxA > mA + 8.0f || mxB > mB + 8.0f)) {
            const float nA = (t == 0) ? mxA : max2f(mA, mxA), nB = (t == 0) ? mxB : max2f(mB, mxB);
            const float fA = fexp2(mA - nA), fB = fexp2(mB - nB); mA = nA; mB = nB; lA *= fA; lB *= fB;
#pragma unroll
            for (int r = 0; r < 16; ++r) { a0[r] *= fA; a1[r] *= fA; b0[r] *= fB; b1[r] *= fB; }
        }
        float sA = 0.f, sB = 0.f;
#pragma unroll
        for (int r = 0; r < 16; ++r) { pa0[r] = fexp2(pa0[r] - mA); pa1[r] = fexp2(pa1[r] - mA); sA += pa0[r] + pa1[r]; }
        pwA[0] = (u32x4){cvtpk(pa0[0], pa0[1]), cvtpk(pa0[2], pa0[3]), cvtpk(pa0[4], pa0[5]), cvtpk(pa0[6], pa0[7])};
        pwA[1] = (u32x4){cvtpk(pa0[8], pa0[9]), cvtpk(pa0[10], pa0[11]), cvtpk(pa0[12], pa0[13]), cvtpk(pa0[14], pa0[15])};
        pwA[2] = (u32x4){cvtpk(pa1[0], pa1[1]), cvtpk(pa1[2], pa1[3]), cvtpk(pa1[4], pa1[5]), cvtpk(pa1[6], pa1[7])};
        pwA[3] = (u32x4){cvtpk(pa1[8], pa1[9]), cvtpk(pa1[10], pa1[11]), cvtpk(pa1[12], pa1[13]), cvtpk(pa1[14], pa1[15])};
        LAS const unsigned char* vp = cur + 8192 + vlane;
#pragma unroll
        for (int ks = 0; ks < 4; ++ks) {
            const s16x4 lo0 = vtr(vp + ks * 1024), hi0 = vtr(vp + ks * 1024 + 512), lo1 = vtr(vp + 4096 + ks * 1024), hi1 = vtr(vp + 4096 + ks * 1024 + 512);
            const bf16x8 v0 = (bf16x8){lo0[0], lo0[1], lo0[2], lo0[3], hi0[0], hi0[1], hi0[2], hi0[3]};
            const bf16x8 v1 = (bf16x8){lo1[0], lo1[1], lo1[2], lo1[3], hi1[0], hi1[1], hi1[2], hi1[3]};
            const bf16x8 pa = __builtin_bit_cast(bf16x8, pwA[ks]);
            a0 = __builtin_amdgcn_mfma_f32_32x32x16_bf16(v0, pa, a0, 0, 0, 0);
            a1 = __builtin_amdgcn_mfma_f32_32x32x16_bf16(v1, pa, a1, 0, 0, 0);
#pragma unroll
            for (int r = 4 * ks; r < 4 * ks + 4; ++r) { pb0[r] = fexp2(pb0[r] - mB); pb1[r] = fexp2(pb1[r] - mB); sB += pb0[r] + pb1[r]; }
        }
        lA += xhalf_sum(sA); lB += xhalf_sum(sB);
        pwB[0] = (u32x4){cvtpk(pb0[0], pb0[1]), cvtpk(pb0[2], pb0[3]), cvtpk(pb0[4], pb0[5]), cvtpk(pb0[6], pb0[7])};
        pwB[1] = (u32x4){cvtpk(pb0[8], pb0[9]), cvtpk(pb0[10], pb0[11]), cvtpk(pb0[12], pb0[13]), cvtpk(pb0[14], pb0[15])};
        pwB[2] = (u32x4){cvtpk(pb1[0], pb1[1]), cvtpk(pb1[2], pb1[3]), cvtpk(pb1[4], pb1[5]), cvtpk(pb1[6], pb1[7])};
        pwB[3] = (u32x4){cvtpk(pb1[8], pb1[9]), cvtpk(pb1[10], pb1[11]), cvtpk(pb1[12], pb1[13]), cvtpk(pb1[14], pb1[15])};
#pragma unroll
        for (int ks = 0; ks < 4; ++ks) {
            const s16x4 lo0 = vtr(vp + ks * 1024), hi0 = vtr(vp + ks * 1024 + 512), lo1 = vtr(vp + 4096 + ks * 1024), hi1 = vtr(vp + 4096 + ks * 1024 + 512);
            const bf16x8 v0 = (bf16x8){lo0[0], lo0[1], lo0[2], lo0[3], hi0[0], hi0[1], hi0[2], hi0[3]};
            const bf16x8 v1 = (bf16x8){lo1[0], lo1[1], lo1[2], lo1[3], hi1[0], hi1[1], hi1[2], hi1[3]};
            const bf16x8 pb = __builtin_bit_cast(bf16x8, pwB[ks]);
            b0 = __builtin_amdgcn_mfma_f32_32x32x16_bf16(v0, pb, b0, 0, 0, 0);
            b1 = __builtin_amdgcn_mfma_f32_32x32x16_bf16(v1, pb, b1, 0, 0, 0);
        }
    };
    for (int t = 0; t < NT; ++t) {
        LAS unsigned char* cur = lds + (t & 1) * 16384; LAS unsigned char* nxt = lds + ((t + 1) & 1) * 16384;
        if (t + 1 < NT) { kA = *(const u32x4*)(ksrc + (size_t)(t + 1) * 64 * PQ); vA = *(const u32x4*)(vsrc + (size_t)(t + 1) * 64 * PQ); }
        tile(t, cur);
        if (t + 1 < NT) { *(LAS u32x4*)(nxt + kdst) = kA; *(LAS u32x4*)(nxt + vdst) = vA; }
        __syncthreads();
    }
    const float ia = 1.0f / lA, ib = lam / lB; float ss = 0.f;
#pragma unroll
    for (int i = 0; i < 16; ++i) { a0[i] = a0[i] * ia - b0[i] * ib; a1[i] = a1[i] * ia - b1[i] * ib; ss += a0[i] * a0[i] + a1[i] * a1[i]; }
    ss = xhalf_sum(ss);
    const float rms = 1.0f / sqrtf(ss * (1.0f / 64.0f) + LN_EPS) * post;
#pragma unroll
    for (int g = 0; g < 4; ++g) { const f32x4 g0 = *(const f32x4*)(subg + 8 * g + 4 * hi), g1 = *(const f32x4*)(subg + 32 + 8 * g + 4 * hi);
#pragma unroll
        for (int jj = 0; jj < 4; ++jj) { a0[4 * g + jj] *= rms * g0[jj]; a1[4 * g + jj] *= rms * g1[jj]; } }
    store_oT(O + qrow * DM + 256 + head * 64, a0, a1, hi);
}


#define XB_TMO      128
#define XB_XCNT(j)  (256  + 64 * (j))
#define XB_XSUB(j)  (1280 + 64 * (j))
#define XB_XGEN(j)  (2304 + 64 * (j))
#define XB_TOP      3328
#define XB_TOPGEN   3392
#define XCD_BAR_WORDS 3456
#define XB_SPIN_CAP (1u << 18)
DI unsigned xb_ld(unsigned* p)              { return __hip_atomic_load(p, __ATOMIC_RELAXED, __HIP_MEMORY_SCOPE_AGENT); }
DI unsigned xb_add(unsigned* p, unsigned v) { return __hip_atomic_fetch_add(p, v, __ATOMIC_RELAXED, __HIP_MEMORY_SCOPE_AGENT); }
DI unsigned xb_xcc_id() { return (unsigned)__builtin_amdgcn_s_getreg((3 << 11) | 20) & 0xFu; }
#define XB_SPIN(cond, bar) do { unsigned _sp = 0; while (cond) { __builtin_amdgcn_s_sleep(1); \
    if ((++_sp & 255u) == 0u) { if (xb_ld(&(bar)[XB_TMO])) break; if (_sp > XB_SPIN_CAP) { atomicAdd(&(bar)[XB_TMO], 1u); break; } } } } while (0)
struct XcdBarrier { unsigned* bar; unsigned x; volatile LAS unsigned* st; int wid; };
DI XcdBarrier xcd_barrier_post(unsigned* bar, volatile LAS unsigned* st, int wid) {
    XcdBarrier b; b.bar = bar; b.x = xb_xcc_id(); b.st = st; b.wid = wid;
    if (wid == 0 && lane_now() == 0) (void)xb_add(&bar[XB_XCNT(b.x)], 1u);
    return b;
}
DI void xcd_barrier_complete(unsigned* bar, unsigned x, unsigned& nloc, unsigned& nx) {
    const unsigned G = gridDim.x * gridDim.y * gridDim.z;
    unsigned sum, cnt, mine, sp = 0u;
    for (;;) {
        sum = 0u; cnt = 0u; mine = 0u;
#pragma unroll
        for (unsigned j = 0; j < 16; ++j) { const unsigned c = xb_ld(&bar[XB_XCNT(j)]); sum += c; cnt += (c > 0u) ? 1u : 0u; mine = (j == x) ? c : mine; }
        if (sum == G) break;
        __builtin_amdgcn_s_sleep(1);
        if ((++sp & 255u) == 0u) { if (xb_ld(&bar[XB_TMO])) break; if (sp > XB_SPIN_CAP) { atomicAdd(&bar[XB_TMO], 1u); break; } }
    }
    nloc = mine > 0u ? mine : 1u; nx = cnt > 0u ? cnt : 1u;
}
DI void xcd_barrier(const XcdBarrier& b) {
    asm volatile("s_waitcnt vmcnt(0)" ::: "memory");
    __syncthreads();
    if (b.wid == 0 && lane_now() == 0) {
        unsigned* bar = b.bar;
        __builtin_amdgcn_s_waitcnt(0);
        unsigned nloc = b.st[0], nx = b.st[1];
        if (nloc == 0u) { xcd_barrier_complete(bar, b.x, nloc, nx); b.st[0] = nloc; b.st[1] = nx; }
        const unsigned old = xb_add(&bar[XB_XSUB(b.x)], 1u);
        const unsigned gen = old / nloc;
        if (old + 1u == (gen + 1u) * nloc) {
            __builtin_amdgcn_fence(__ATOMIC_RELEASE, "agent");
            asm volatile("s_waitcnt vmcnt(0)" ::: "memory");
            const unsigned og = xb_add(&bar[XB_TOP], 1u);
            const unsigned tg = og / nx;
            if (og + 1u == (tg + 1u) * nx) xb_add(&bar[XB_TOPGEN], 1u);
            else XB_SPIN(xb_ld(&bar[XB_TOPGEN]) == tg, bar);
            __builtin_amdgcn_fence(__ATOMIC_ACQUIRE, "agent");
            xb_add(&bar[XB_XGEN(b.x)], 1u);
            asm volatile("s_waitcnt vmcnt(0)" ::: "memory");
        } else {
            XB_SPIN(xb_ld(&bar[XB_XGEN(b.x)]) == gen, bar);
            __builtin_amdgcn_fence(__ATOMIC_ACQUIRE, "agent");
            asm volatile("s_waitcnt vmcnt(0)" ::: "memory");
        }
    }
    __syncthreads();
}

__global__ void __launch_bounds__(512, 2) fwd_megakernel(Params p) {
    extern __shared__ __attribute__((aligned(16))) unsigned char lds_raw[];
    cg::grid_group grid = cg::this_grid();
    LAS unsigned char* lds = (LAS unsigned char*)lds_raw;
    const int tid = threadIdx.x, lane = tid & 63, wid = __builtin_amdgcn_readfirstlane(tid >> 6);
    const int G = gridDim.x, bx = blockIdx.x;
    const int gw = bx * 8 + wid, NGW = G * 8;
    const int vbx = ((G & 7) == 0) ? (bx & 7) * (G >> 3) + (bx >> 3) : bx;
    unsigned char* ws = p.ws;
    float* modp = (float*)(ws + WS_MODP); float* modv = (float*)(ws + WS_MODV);
    float* cosC = (float*)(ws + WS_ROPEC); float* sinC = cosC + 8192 * 32; float* cosB = (float*)(ws + WS_ROPEB); float* sinB = cosB + 8192 * 16;
    float* stA = (float*)(ws + WS_STA); float* stB = (float*)(ws + WS_STB);
    bf16_t* XN = (bf16_t*)(ws + WS_XN); bf16_t* PROJ = (bf16_t*)(ws + WS_PROJ); bf16_t* ACT = PROJ;
    bf16_t* PART = (bf16_t*)(ws + WS_PART); float* ML = (float*)(ws + WS_ML); bf16_t* YB = (bf16_t*)(ws + WS_YB);
    LAS unsigned char* wl = lds + wid * 16384;
    LAS float* wscr = (LAS float*)(lds + LDS_SCR + wid * 2560);
    volatile LAS unsigned* bst = (volatile LAS unsigned*)(lds + LDS_SCR + 8 * 2560);
    if (tid < 2) bst[tid] = 0u;
    __syncthreads();
    XcdBarrier xbar = xcd_barrier_post((unsigned*)ws, bst, wid);
#define GSYNC() xcd_barrier(xbar)

#ifndef NO_P0
    {
        LAS float* scr = (LAS float*)wl;
        constexpr int I_IN = 16 * 96, I_OUT = 16 * 32, I_GU = 16 * 176, I_DN = 44 * 32, I_L = I_IN + I_OUT + I_GU + I_DN;
        for (int it = gw; it < 2 * I_L; it += NGW) {
            const int l = it / I_L; int r = it % I_L; bf16_t* wb = (bf16_t*)(ws + WS_W + (size_t)l * W_LAYER);
            if (r < I_IN) { transpose_item(p.w_in + (size_t)l * DM * NQKV, DM, NQKV, (bf16_t*)((unsigned char*)wb + W_IN), 0, scr, r, lane); continue; } r -= I_IN;
            if (r < I_OUT) { transpose_item(p.w_out + (size_t)l * DM * DM, DM, DM, (bf16_t*)((unsigned char*)wb + W_OUT), 1, scr, r, lane); continue; } r -= I_OUT;
            if (r < I_GU) { transpose_item(p.w_gu + (size_t)l * DM * NGU, DM, NGU, (bf16_t*)((unsigned char*)wb + W_GU), 2, scr, r, lane); continue; } r -= I_GU;
            transpose_item(p.w_down + (size_t)l * FF * DM, FF, DM, (bf16_t*)((unsigned char*)wb + W_DOWN), 1, scr, r, lane);
        }
        for (int e = bx * 512 + tid; e < 8192 * 48; e += G * 512) {
            float sv, cv;
            if (e < 8192 * 32) { const int pos = e >> 5, i = e & 31; const float ang = (float)pos * p.invfC[i]; sincos_d(ang, sv, cv); cosC[e] = cv; sinC[e] = sv; }
            else { const int e2 = e - 8192 * 32; const int pos = e2 >> 4, i = e2 & 15; const float ang = (float)pos * p.invfB[i]; sincos_d(ang, sv, cv); cosB[e2] = cv; sinB[e2] = sv; }
        }
        __syncthreads();
        LAS float* sl = (LAS float*)lds;
        for (int it = bx; it < 2 * 12 * 8; it += G) {
            const int ks = it & 7, cb = (it >> 3) % 12, l = it / 96;
            for (int idx = tid; idx < NSEQ * 128; idx += 512) { const int s = idx >> 7, kk = idx & 127;
                const float cvv = (s < 8) ? p.c[0][s * DM + ks * 128 + kk] : p.c[1][(s - 8) * DM + ks * 128 + kk];
                sl[idx] = cvv / (1.0f + __expf(-cvv)); }
            __syncthreads();
            float acc[NSEQ];
#pragma unroll
            for (int s = 0; s < NSEQ; ++s) acc[s] = 0.f;
            const float* wp = p.w_ada + ((size_t)l * DM + ks * 128) * 6144 + cb * 512 + tid;
            for (int kk = 0; kk < 128; kk += 4) {
                const float w0 = wp[(size_t)kk * 6144], w1 = wp[(size_t)(kk + 1) * 6144], w2 = wp[(size_t)(kk + 2) * 6144], w3 = wp[(size_t)(kk + 3) * 6144];
#pragma unroll
                for (int s = 0; s < NSEQ; ++s) { const f32x4 sv = *(LAS const f32x4*)(sl + s * 128 + kk); acc[s] += (sv.x * w0 + sv.y * w1) + (sv.z * w2 + sv.w * w3); }
            }
#pragma unroll
            for (int s = 0; s < NSEQ; ++s) modp[(((size_t)ks * 2 + l) * NSEQ + s) * 6144 + cb * 512 + tid] = acc[s];
            __syncthreads();
        }
    }
#endif
    grid.sync();
    for (int e = bx * 512 + tid; e < 2 * NSEQ * 6144; e += G * 512) {
        const int jcol = e % 6144, l = e / (NSEQ * 6144);
        float v = p.b_ada[l * 6144 + jcol];
#pragma unroll
        for (int ks = 0; ks < 8; ++ks) v += modp[(size_t)ks * 2 * NSEQ * 6144 + e];
        modv[e] = v;
    }
    GSYNC();

    pg8::StaticOrder SO;
    for (int hf = 0; hf < 2; ++hf) {
        const int S = hf ? 2048 : 8192, Sshift = hf ? 11 : 13, seq0 = hf ? 8 : 0, nseq = hf ? 32 : 8;
        const float* xin = p.x[hf]; float* outh = p.out + (size_t)hf * TH * DM;
        for (int l = 0; l < 2; ++l) {
            const unsigned char* wb = ws + WS_W + (size_t)l * W_LAYER;
            const bf16_t* Win_t = (const bf16_t*)(wb + W_IN); const bf16_t* Wout_t = (const bf16_t*)(wb + W_OUT);
            const bf16_t* Wgu_t = (const bf16_t*)(wb + W_GU); const bf16_t* Wdn_t = (const bf16_t*)(wb + W_DOWN);
            const float* modbase = modv + ((size_t)l * NSEQ + seq0) * 6144;
            if (l == 0) ln_pass<false, false>(xin, XN, stA, nullptr, nullptr, modbase, 0, Sshift, gw, lane_now());
            else ln_pass<true, true>(YB, XN, stA, p.ln2_g + (l - 1) * DM, p.ln2_b + (l - 1) * DM, modbase, 0, Sshift, gw, lane_now());
            GSYNC();
#ifndef NO_QKV
            { pg8::Gemm g{XN, Win_t, TH, NQKV, DM}; SO.init(TH, NQKV, G, bx);
              pg8::EpiQKV E{PROJ, cosC, sinC, cosB, sinB, S - 1, lds + LDS_SCR};
              pg8::gemm_phase<pg8::EpiQKV>(lds, g, SO, E, wid); }
#endif
            GSYNC();
            {
#ifndef NO_A
                for (int rep = 0; rep < REP_AC; ++rep) walk_na(Sshift, nseq, l, PROJ, XN, p.na_rpb, lds, wscr, wid, lane_now(), vbx * 2 + (wid >> 2));
#endif
#ifndef NO_C
                for (int rep = 0; rep < REP_AC; ++rep) {
                    walk_dil<0>(Sshift, nseq, 2, 0, PROJ, XN, PART, ML, lds, wid, lane_now(), vbx * 2 + (wid >> 2));
                    walk_dil<0>(Sshift, nseq, 4, 1, PROJ, XN, PART, ML, lds, wid, lane_now(), vbx * 2 + (wid >> 2)); }
#endif
                __syncthreads();
#ifndef NO_B
                float d01 = 0.f, d23 = 0.f; const float* lf = p.diff_lambda + l * 128;
                for (int i = 0; i < 32; ++i) { d01 += lf[i] * lf[32 + i]; d23 += lf[64 + i] * lf[96 + i]; }
                const float lam = __expf(d01) - __expf(d23) + p.lambda_init[l]; const float post = 1.0f - p.lambda_init[l];
                const int nB = nseq * 4 * (S >> 8);
                for (int rep = 0; rep < REP_B; ++rep)
                for (int u = vbx; u < nB; u += G) attn_diff_unit(u, Sshift, lam, post, p.diff_subln_g + l * 64, PROJ, XN, lds, wid, lane_now());
#endif
            }
            GSYNC();
            {
#ifndef NO_C1
              for (int rep = 0; rep < REP_AC; ++rep) walk_dil<1>(Sshift, nseq, 0, 0, PROJ, XN, PART, ML, lds, wid, lane_now(), vbx * 2 + (wid >> 2));
#endif
              __syncthreads(); }
            GSYNC();
#ifndef NO_RES
            { pg8::Gemm g{XN, Wout_t, TH, DM, DM}; SO.init(TH, DM, G, bx);
              if (l == 0) { pg8::EpiRes<false, true> E{xin, YB, nullptr, p.ln2_g, p.ln2_b, modbase + 2 * 1024, Sshift};
                  pg8::gemm_phase<pg8::EpiRes<false, true>>(lds, g, SO, E, wid); }
              else { pg8::EpiRes<true, true> E{YB, YB, stA, p.ln2_g + (l - 1) * DM, p.ln2_b + (l - 1) * DM, modbase + 2 * 1024, Sshift};
                  pg8::gemm_phase<pg8::EpiRes<true, true>>(lds, g, SO, E, wid); } }
#endif
            GSYNC();
            ln_pass<true, true>(YB, XN, stB, p.ln1_g + l * DM, p.ln1_b + l * DM, modbase, 3, Sshift, gw, lane_now());
            GSYNC();
#ifndef NO_GU
            { pg8::Gemm g{XN, Wgu_t, TH, NGU, DM}; SO.init(TH, NGU, G, bx);
              pg8::EpiSwiGLU E{ACT};
              pg8::gemm_phase<pg8::EpiSwiGLU>(lds, g, SO, E, wid); }
#endif
            GSYNC();
#ifndef NO_RES
            { pg8::Gemm g{ACT, Wdn_t, TH, DM, FF}; SO.init(TH, DM, G, bx);
              if (l == 0) { pg8::EpiRes<true, true> E{YB, YB, stB, p.ln1_g + l * DM, p.ln1_b + l * DM, modbase + 5 * 1024, Sshift};
                  pg8::gemm_phase<pg8::EpiRes<true, true>>(lds, g, SO, E, wid); }
              else { pg8::EpiRes<true, false> E{YB, outh, stB, p.ln1_g + l * DM, p.ln1_b + l * DM, modbase + 5 * 1024, Sshift};
                  pg8::gemm_phase<pg8::EpiRes<true, false>>(lds, g, SO, E, wid); } }
#endif
            GSYNC();
        }
        final_ln(outh, p.ln2_g + DM, p.ln2_b + DM, gw, lane_now());
    }
}

extern "C" void kernel_launch(void* const* d_in, const int* in_sizes, int n_in, void* d_out, int out_size, void* d_ws, size_t ws_size, hipStream_t stream) {
    static int grid = 0;
    if (grid == 0) {
        if (n_in != 17 || ws_size < WS_END) { fprintf(stderr, "kernel_launch: unexpected inputs (%d) or workspace (%zu < %zu)\n", n_in, ws_size, (size_t)WS_END); grid = -1; return; }
        int dev = 0, cus = 0, per_cu = 0;
        hipGetDevice(&dev); hipDeviceGetAttribute(&cus, hipDeviceAttributeMultiprocessorCount, dev);
        hipFuncSetAttribute((const void*)fwd_megakernel, hipFuncAttributeMaxDynamicSharedMemorySize, LDS_BYTES);
        hipOccupancyMaxActiveBlocksPerMultiprocessor(&per_cu, (const void*)fwd_megakernel, 512, LDS_BYTES);
        if (per_cu < 1) { fprintf(stderr, "kernel_launch: occupancy query says %d blocks per CU\n", per_cu); per_cu = 1; }
        (void)hipGetLastError();
        if (cus != 256) { fprintf(stderr, "kernel_launch: built for a 256-CU device (got %d)\n", cus); grid = -1; return; }
        grid = 256;
    }
    if (grid < 0) return;
    Params p{};
    p.x[0] = (const float*)d_in[0]; p.x[1] = (const float*)d_in[1]; p.c[0] = (const float*)d_in[2]; p.c[1] = (const float*)d_in[3];
    p.w_ada = (const float*)d_in[4]; p.b_ada = (const float*)d_in[5]; p.w_in = (const float*)d_in[6]; p.na_rpb = (const float*)d_in[7];
    p.diff_lambda = (const float*)d_in[8]; p.diff_subln_g = (const float*)d_in[9]; p.w_out = (const float*)d_in[10];
    p.ln1_g = (const float*)d_in[11]; p.ln1_b = (const float*)d_in[12]; p.w_gu = (const float*)d_in[13]; p.w_down = (const float*)d_in[14];
    p.ln2_g = (const float*)d_in[15]; p.ln2_b = (const float*)d_in[16];
    p.out = (float*)d_out; p.ws = (unsigned char*)d_ws;
    for (int i = 0; i < 32; ++i) p.invfC[i] = powf(10000.0f, -(float)i / 32.0f);
    for (int i = 0; i < 16; ++i) p.invfB[i] = powf(10000.0f, -(float)i / 16.0f);
    for (int l = 0; l < 2; ++l) p.lambda_init[l] = (float)(0.8 - 0.6 * exp(-0.3 * (double)l));
    if (hipMemsetAsync(d_ws, 0, 16384, stream) != hipSuccess) { fprintf(stderr, "kernel_launch: memset of the barrier words failed\n"); return; }
    void* args[] = {&p};
    hipError_t e = hipLaunchCooperativeKernel((const void*)fwd_megakernel, dim3(grid), dim3(512), args, LDS_BYTES, stream);
    if (e != hipSuccess) fprintf(stderr, "cooperative launch failed: %s (grid %d)\n", hipGetErrorString(e), grid);
}
```

```cpp
#include <hip/hip_runtime.h>
#include <hip/hip_cooperative_groups.h>
#include <cstdio>
#include <cstdint>
#include <cmath>
namespace cg = cooperative_groups;

#define DI __device__ __forceinline__
#define LAS __attribute__((address_space(3)))
typedef unsigned short bf16_t;
typedef short bf16x8 __attribute__((ext_vector_type(8)));
typedef short s16x4 __attribute__((ext_vector_type(4)));
typedef float f32x2 __attribute__((ext_vector_type(2)));
typedef float f32x4 __attribute__((ext_vector_type(4)));
typedef float f32x16 __attribute__((ext_vector_type(16)));
typedef unsigned u32x2 __attribute__((ext_vector_type(2)));
typedef unsigned u32x4 __attribute__((ext_vector_type(4)));
typedef __bf16 bf16x2_t __attribute__((ext_vector_type(2)));

#ifndef REP_B
#define REP_B 1
#endif
#ifndef REP_AC
#define REP_AC 1
#endif
constexpr float LOG2E = 1.4426950408889634f;
constexpr int DM = 1024, TH = 65536, NQKV = 3072, FF = 2816, NGU = 5632, NSEQ = 40;
constexpr int PQ = 3136;
constexpr float LN_EPS = 1e-5f;
constexpr float ALPHA = 1.4142135623730951f;

DI unsigned cvtpk(float lo, float hi) { f32x2 v = {lo, hi}; bf16x2_t b = __builtin_convertvector(v, bf16x2_t); return __builtin_bit_cast(unsigned, b); }
DI float bf_lo(unsigned u) { return __uint_as_float(u << 16); }
DI float bf_hi(unsigned u) { return __uint_as_float(u & 0xffff0000u); }
DI float fexp2(float x) { return __builtin_amdgcn_exp2f(x); }
template <class T> DI T* opqp(T* x) { asm volatile("" : "+s"(x)); return x; }
DI int lane_now() { int x; asm volatile("v_mbcnt_lo_u32_b32 %0, -1, 0\n\tv_mbcnt_hi_u32_b32 %0, -1, %0" : "=&v"(x)); return x; }
DI void lds_barrier() { asm volatile("s_waitcnt lgkmcnt(0)\n\ts_barrier" ::: "memory"); }
DI int opq(int x) { asm volatile("" : "+v"(x)); return x; }

namespace pg8 {
constexpr int BM = 256, BK = 64, HALF = 128, HTB = HALF * BK * 2, STAGE_BYTES = 8 * HTB, NXCD = 8, WGM = 8;
DI int lds_byte(int r, int c) { const int st = (r >> 4) * 2 + (c >> 5), rr = r & 15, cc = c & 31, ob = rr * 64 + cc * 2; return st * 1024 + (ob ^ (((ob >> 9) & 1) << 5)); }
DI void stage_rc(int b, int& R, int& C) { const int st = b / 1024, sb = b % 1024, swz = sb ^ (((sb >> 9) & 1) << 5); R = (st >> 1) * 16 + swz / 64; C = (st & 1) * 32 + (swz % 64) / 2; }
DI int perm32(int rho) { const int n = rho >> 4, i = rho & 15; return 8 * (i >> 2) + 4 * n + (i & 3); }
struct Unit { int pm, pn; };
struct Gemm { const bf16_t* A; const bf16_t* Bt; int M, N, K; };
struct StaticOrder {
    int nM, nN, nwg, G, c;
    DI void init(int M, int N, int G_, int c_) { nM = M / BM; nN = N / BM; nwg = nM * nN; G = G_; c = c_; }
    DI bool next(int i, Unit& u) const {
        const long L = (long)i * G + c; if (L >= nwg) return false;
        int wgid = (int)L; { const int q = nwg / NXCD, r = nwg % NXCD, xcd = wgid % NXCD, off = wgid / NXCD; wgid = (xcd < r ? xcd * (q + 1) : r * (q + 1) + (xcd - r) * q) + off; }
        const int nig = WGM * nN, gid = wgid / nig, fm = gid * WGM, gsz = (nM - fm) < WGM ? (nM - fm) : WGM;
        u.pm = fm + ((wgid % nig) % gsz); u.pn = (wgid % nig) / gsz; return true;
    }
};
template <class Epi>
DI void gemm_phase(LAS unsigned char* lds, const Gemm g, const StaticOrder& S, const Epi& E, int wid) {
    const int lane = lane_now(), tid = wid * 64 + lane, wr = wid >> 2, wc = wid & 3, fr = lane & 15, fq = lane >> 4;
    const int K = g.K, nt = K / BK;
    unsigned voffA[2], voffB[2];
#pragma unroll
    for (int i = 0; i < 2; ++i) { int R, C; stage_rc(tid * 16 + i * 8192, R, C); const int Rb = (R & ~31) + perm32(R & 31);
        voffA[i] = (unsigned)(R * K + C) * 2u; voffB[i] = (unsigned)(Rb * K + C) * 2u; }
    const size_t kstep = (size_t)(BK * 2);
    const size_t hstep = (size_t)HALF * K * 2;
    const size_t tstep = 2 * hstep;
    const unsigned ldsw = (unsigned)wid * 1024u;
    const int aoff = lds_byte(wr * 64 + fr, fq * 8), boff = lds_byte(wc * 32 + fr, fq * 8);
#define PG8_SA(b, h) (((b) * 2 + (h)) * HTB)
#define PG8_SB(b, h) ((4 + (b) * 2 + (h)) * HTB)
#define PG8_STAGE(bufoff, gbase, voff) do { _Pragma("unroll") for (int _i = 0; _i < 2; ++_i) \
        __builtin_amdgcn_global_load_lds((const unsigned*)((const char*)(gbase) + (voff)[_i]), (LAS unsigned*)(lds + (bufoff) + ldsw + _i * 8192), 16, 0, 0); } while (0)
#define PG8_LDA(dst, b, h) do { _Pragma("unroll") for (int m = 0; m < 4; ++m) _Pragma("unroll") for (int k = 0; k < 2; ++k) dst[m][k] = *(const LAS bf16x8*)(lds + PG8_SA(b, h) + aoff + m * 2048 + k * 1024); } while (0)
#define PG8_LDB(dst, b, h) do { _Pragma("unroll") for (int n = 0; n < 2; ++n) _Pragma("unroll") for (int k = 0; k < 2; ++k) dst[n][k] = *(const LAS bf16x8*)(lds + PG8_SB(b, h) + boff + n * 2048 + k * 1024); } while (0)
#define PG8_MMA(ai, bj, At, Bt) do { __builtin_amdgcn_s_setprio(1); _Pragma("unroll") for (int m = 0; m < 4; ++m) _Pragma("unroll") for (int n = 0; n < 2; ++n) _Pragma("unroll") for (int k = 0; k < 2; ++k) \
        acc[ai][bj][m][n] = __builtin_amdgcn_mfma_f32_16x16x32_bf16(Bt[n][k], At[m][k], acc[ai][bj][m][n], 0, 0, 0); __builtin_amdgcn_s_setprio(0); } while (0)
#define PG8_WAIT_V(n) asm volatile("s_waitcnt vmcnt(" #n ")" ::: "memory")
#define PG8_WAIT_L(n) asm volatile("s_waitcnt lgkmcnt(" #n ")" ::: "memory")
#define PG8_BAR __builtin_amdgcn_s_barrier()
#define PG8_SCHED __builtin_amdgcn_sched_barrier(0)
    Unit cur, nxt; int ui = 0;
    if (!S.next(0, cur)) return;
    f32x4 acc[2][2][4][2];
#pragma unroll
    for (int a = 0; a < 2; ++a)
#pragma unroll
        for (int b = 0; b < 2; ++b)
#pragma unroll
            for (int m = 0; m < 4; ++m)
#pragma unroll
                for (int n = 0; n < 2; ++n) acc[a][b][m][n] = (f32x4){0.f, 0.f, 0.f, 0.f};
    bf16x8 At[4][2], B0[2][2], B1[2][2];
    const char* cA = (const char*)g.A + (size_t)cur.pm * tstep; const char* cB = (const char*)g.Bt + (size_t)cur.pn * tstep;
    PG8_STAGE(PG8_SB(0, 0), cB, voffB); PG8_STAGE(PG8_SB(0, 1), cB + hstep, voffB); PG8_STAGE(PG8_SA(0, 0), cA, voffA); PG8_STAGE(PG8_SA(0, 1), cA + hstep, voffA);
    if (wr == 1) PG8_BAR;
    PG8_WAIT_V(2); PG8_BAR;
    PG8_STAGE(PG8_SB(1, 0), cB + kstep, voffB); PG8_STAGE(PG8_SA(1, 0), cA + kstep, voffA); PG8_STAGE(PG8_SB(1, 1), cB + hstep + kstep, voffB);
    PG8_WAIT_V(6); PG8_BAR;
    for (;;) {
        const bool has_next = S.next(ui + 1, nxt);
        const char* nA = has_next ? (const char*)g.A + (size_t)nxt.pm * tstep : cA; const char* nB = has_next ? (const char*)g.Bt + (size_t)nxt.pn * tstep : cB;
        for (int t = 0; t < nt; t += 2) {
            const bool last = (t == nt - 2);
            const char* a1 = cA + (size_t)(t + 1) * kstep;
            const char* a2 = last ? nA : cA + (size_t)(t + 2) * kstep; const char* b2 = last ? nB : cB + (size_t)(t + 2) * kstep;
            const char* a3 = a2 + kstep; const char* b3 = b2 + kstep;
            PG8_LDB(B0, 0, 0); PG8_LDB(B1, 0, 1); PG8_SCHED; PG8_LDA(At, 0, 0); PG8_STAGE(PG8_SA(1, 1), a1 + hstep, voffA);
            PG8_WAIT_V(8); PG8_WAIT_L(0); PG8_BAR; PG8_MMA(0, 0, At, B0); PG8_MMA(0, 1, At, B1); PG8_BAR; PG8_SCHED;
            PG8_LDA(At, 0, 1); PG8_STAGE(PG8_SB(0, 0), b2, voffB); PG8_STAGE(PG8_SB(0, 1), b2 + hstep, voffB); PG8_STAGE(PG8_SA(0, 0), a2, voffA);
            PG8_WAIT_V(8); PG8_WAIT_L(0); PG8_BAR; PG8_MMA(1, 0, At, B0); PG8_MMA(1, 1, At, B1); PG8_BAR; PG8_SCHED;
            PG8_LDB(B0, 1, 0); PG8_LDB(B1, 1, 1); PG8_SCHED; PG8_LDA(At, 1, 0); PG8_STAGE(PG8_SA(0, 1), a2 + hstep, voffA);
            PG8_WAIT_V(8); PG8_WAIT_L(0); PG8_BAR; PG8_MMA(0, 0, At, B0); PG8_MMA(0, 1, At, B1); PG8_BAR; PG8_SCHED;
            PG8_LDA(At, 1, 1); PG8_STAGE(PG8_SB(1, 0), b3, voffB); PG8_STAGE(PG8_SB(1, 1), b3 + hstep, voffB); PG8_STAGE(PG8_SA(1, 0), a3, voffA);
            PG8_WAIT_V(8); PG8_WAIT_L(0); PG8_BAR; PG8_MMA(1, 0, At, B0); PG8_MMA(1, 1, At, B1); PG8_BAR; PG8_SCHED;
        }
        if (wr == 0) PG8_BAR;
        E(acc, cur, wr, wc, fr, fq);
        if (!has_next) break;
#pragma unroll
        for (int a = 0; a < 2; ++a)
#pragma unroll
            for (int b = 0; b < 2; ++b)
#pragma unroll
                for (int m = 0; m < 4; ++m)
#pragma unroll
                    for (int n = 0; n < 2; ++n) acc[a][b][m][n] = (f32x4){0.f, 0.f, 0.f, 0.f};
        cur = nxt; cA = nA; cB = nB; ++ui;
        if (wr == 1) PG8_BAR;
    }
    PG8_WAIT_V(0);
    PG8_BAR;
#undef PG8_SA
#undef PG8_SB
#undef PG8_STAGE
#undef PG8_LDA
#undef PG8_LDB
#undef PG8_MMA
#undef PG8_WAIT_V
#undef PG8_WAIT_L
#undef PG8_BAR
#undef PG8_SCHED
}

struct EpiQKV {
    bf16_t* P; const float* cosC; const float* sinC; const float* cosB; const float* sinB; int Smask; LAS unsigned char* scr;
    DI void operator()(const f32x4 (&acc)[2][2][4][2], const Unit& u, int wr, int wc, int fr, int fq) const {
        const int pn = u.pn; const int row0 = u.pm * BM + wr * 64;
        const int kind = (pn == 3 || pn == 4) ? 1 : ((pn >= 6 && pn <= 9) ? 2 : 0);
        const float sc = (pn == 0 || pn == 6 || pn == 7) ? 0.125f * LOG2E : (pn == 3 ? 0.17677669529663687f * LOG2E : 1.f);
        LAS unsigned char* stg = scr + (wr * 4 + wc) * 2560;
        const int lane = fq * 16 + fr;
        const int off1 = (kind == 1) ? ((fq >> 1) * 32 + 8 * (fq & 1)) * 2 : (8 * fq) * 2;
        const int off2 = off1 + ((kind == 1) ? 32 : 64);
        const float* ct = (kind == 2) ? cosC : cosB; const float* st = (kind == 2) ? sinC : sinB;
        const int nf = (kind == 2) ? 32 : 16; const int i0 = (kind == 2) ? 8 * fq : 8 * (fq & 1);
#pragma unroll
        for (int ai = 0; ai < 2; ++ai)
#pragma unroll
            for (int m = 0; m < 4; ++m) { const int rbase = row0 + ai * HALF + m * 16;
                f32x4 a0 = acc[ai][0][m][0], a1 = acc[ai][0][m][1], b0 = acc[ai][1][m][0], b1 = acc[ai][1][m][1];
                if (kind != 0) {
                    const int pos = (rbase + fr) & Smask;
                    const f32x4 c0 = *(const f32x4*)(ct + (size_t)pos * nf + i0), c1 = *(const f32x4*)(ct + (size_t)pos * nf + i0 + 4);
                    const f32x4 s0 = *(const f32x4*)(st + (size_t)pos * nf + i0), s1 = *(const f32x4*)(st + (size_t)pos * nf + i0 + 4);
                    const f32x4 o10 = a0 * c0 - b0 * s0, o11 = a1 * c1 - b1 * s1, o20 = a0 * s0 + b0 * c0, o21 = a1 * s1 + b1 * c1;
                    a0 = o10; a1 = o11; b0 = o20; b1 = o21;
                }
                a0 = a0 * sc; a1 = a1 * sc; b0 = b0 * sc; b1 = b1 * sc;
                u32x4 w1, w2; w1.x = cvtpk(a0[0], a0[1]); w1.y = cvtpk(a0[2], a0[3]); w1.z = cvtpk(a1[0], a1[1]); w1.w = cvtpk(a1[2], a1[3]);
                w2.x = cvtpk(b0[0], b0[1]); w2.y = cvtpk(b0[2], b0[3]); w2.z = cvtpk(b1[0], b1[1]); w2.w = cvtpk(b1[2], b1[3]);
                *(LAS u32x4*)(stg + fr * 144 + off1) = w1; *(LAS u32x4*)(stg + fr * 144 + off2) = w2;
                asm volatile("s_waitcnt lgkmcnt(0)" ::: "memory");
                bf16_t* dst = P + (size_t)rbase * PQ + pn * 256 + wc * 64;
#pragma unroll
                for (int i = 0; i < 2; ++i) { const int pc = i * 64 + lane, row = pc >> 3, ch = pc & 7;
                    const u32x4 v = *(LAS const u32x4*)(stg + row * 144 + ch * 16);
                    *(u32x4*)(dst + (size_t)row * PQ + ch * 8) = v; }
            }
    }
};
template <bool RB, bool OB>
struct EpiRes {
    const void* res; void* out; const float* stats; const float* lng; const float* lnb; const float* gatebase; int Sshift;
    DI void operator()(const f32x4 (&acc)[2][2][4][2], const Unit& u, int wr, int wc, int fr, int fq) const {
        const int row0 = u.pm * BM + wr * 64 + fr; const int seq = (u.pm * BM) >> Sshift; const float* gate = gatebase + (size_t)seq * 6144;
        constexpr int NB = RB ? 4 : 2;
#pragma unroll
        for (int bj = 0; bj < 2; ++bj) { const int col = u.pn * BM + bj * HALF + wc * 32 + 8 * fq;
            const f32x4 g0 = *(const f32x4*)(gate + col), g1 = *(const f32x4*)(gate + col + 4);
            f32x4 lg0 = {1.f, 1.f, 1.f, 1.f}, lg1 = lg0, lb0 = {0.f, 0.f, 0.f, 0.f}, lb1 = lb0;
            if (stats) { lg0 = *(const f32x4*)(lng + col); lg1 = *(const f32x4*)(lng + col + 4); lb0 = *(const f32x4*)(lnb + col); lb1 = *(const f32x4*)(lnb + col + 4); }
#pragma unroll
            for (int b0 = 0; b0 < 8; b0 += NB) {
                u32x4 rw[NB]; f32x4 rf0[RB ? 1 : NB], rf1[RB ? 1 : NB]; f32x2 stv[NB];
#pragma unroll
                for (int q = 0; q < NB; ++q) { const int idx = b0 + q, ai = idx >> 2, m = idx & 3; const int row = row0 + ai * HALF + m * 16; const size_t off = (size_t)row * DM + col;
                    if (RB) rw[q] = *(const u32x4*)((const bf16_t*)res + off);
                    else { rf0[q] = __builtin_nontemporal_load((const f32x4*)((const float*)res + off)); rf1[q] = __builtin_nontemporal_load((const f32x4*)((const float*)res + off + 4)); }
                    stv[q] = stats ? *(const f32x2*)(stats + 2 * (size_t)row) : (f32x2){0.f, 1.f}; }
#pragma unroll
                for (int q = 0; q < NB; ++q) { const int idx = b0 + q, ai = idx >> 2, m = idx & 3; const int row = row0 + ai * HALF + m * 16; const size_t off = (size_t)row * DM + col;
                    f32x4 r0, r1;
                    if (RB) { const u32x4 w = rw[q]; r0 = (f32x4){bf_lo(w.x), bf_hi(w.x), bf_lo(w.y), bf_hi(w.y)}; r1 = (f32x4){bf_lo(w.z), bf_hi(w.z), bf_lo(w.w), bf_hi(w.w)}; }
                    else { r0 = rf0[q]; r1 = rf1[q]; }
                    if (stats) { const f32x2 st = stv[q]; r0 = (r0 - st.x) * st.y * lg0 + lb0; r1 = (r1 - st.x) * st.y * lg1 + lb1; }
                    const f32x4 y0 = r0 * ALPHA + g0 * acc[ai][bj][m][0], y1 = r1 * ALPHA + g1 * acc[ai][bj][m][1];
                    if (OB) { u32x4 w; w.x = cvtpk(y0[0], y0[1]); w.y = cvtpk(y0[2], y0[3]); w.z = cvtpk(y1[0], y1[1]); w.w = cvtpk(y1[2], y1[3]); *(u32x4*)((bf16_t*)out + off) = w; }
                    else { *(f32x4*)((float*)out + off) = y0; *(f32x4*)((float*)out + off + 4) = y1; } }
            } }
    }
};
struct EpiSwiGLU {
    bf16_t* O;
    DI void operator()(const f32x4 (&acc)[2][2][4][2], const Unit& u, int wr, int wc, int fr, int fq) const {
        const int row0 = u.pm * BM + wr * 64 + fr; const int col = u.pn * HALF + wc * 32 + 8 * fq;
#pragma unroll
        for (int ai = 0; ai < 2; ++ai)
#pragma unroll
            for (int m = 0; m < 4; ++m) { float a[8];
#pragma unroll
                for (int n = 0; n < 2; ++n)
#pragma unroll
                    for (int j = 0; j < 4; ++j) { const float gv = acc[ai][0][m][n][j], uv = acc[ai][1][m][n][j];
                        a[4 * n + j] = gv * __builtin_amdgcn_rcpf(1.f + fexp2(-gv * LOG2E)) * uv; }
                u32x4 w; w.x = cvtpk(a[0], a[1]); w.y = cvtpk(a[2], a[3]); w.z = cvtpk(a[4], a[5]); w.w = cvtpk(a[6], a[7]);
                *(u32x4*)(O + (size_t)(row0 + ai * HALF + m * 16) * FF + col) = w; }
    }
};
}

constexpr size_t MiB = 1u << 20;
constexpr size_t WS_MODP = 1 * MiB;
constexpr size_t WS_MODV = 17 * MiB;
constexpr size_t WS_ROPEC = 19 * MiB;
constexpr size_t WS_ROPEB = 21 * MiB;
constexpr size_t WS_STA = 22 * MiB;
constexpr size_t WS_STB = 23 * MiB;
constexpr size_t WS_W = 24 * MiB;
constexpr size_t W_IN = 0, W_OUT = 6 * MiB, W_GU = 8 * MiB, W_DOWN = 19 * MiB, W_LAYER = 25 * MiB;
constexpr size_t WS_XN = 80 * MiB;
constexpr size_t WS_PROJ = 208 * MiB;
constexpr size_t WS_PART = 600 * MiB;
constexpr size_t WS_ML = 728 * MiB;
constexpr size_t WS_YB = 736 * MiB;
constexpr size_t WS_END = 864 * MiB;
constexpr int LDS_BYTES = 131072 + 8 * 2560 + 16;
constexpr int LDS_SCR = 131072;

struct Params {
    const float* x[2]; const float* c[2];
    const float *w_ada, *b_ada, *w_in, *na_rpb, *diff_lambda, *diff_subln_g, *w_out, *ln1_g, *ln1_b, *w_gu, *w_down, *ln2_g, *ln2_b;
    float* out; unsigned char* ws;
    float invfC[32]; float invfB[16]; float lambda_init[2]; int pad[2];
};

DI int dest_row(int ptype, int ncol) {
    if (ptype == 0) {
        const int tile = ncol >> 8, a = ncol & 255;
        if (tile == 3 || tile == 4) { const int head = a >> 6, comp = (a >> 5) & 1, bj = (a >> 4) & 1, i = a & 15; return tile * 256 + bj * 128 + head * 32 + comp * 16 + i; }
        { const int head = a >> 6, bj = (a >> 5) & 1, i = a & 31; return tile * 256 + bj * 128 + head * 32 + i; }
    }
    if (ptype == 2) {
        if (ncol < FF) return (ncol >> 7) * 256 + (ncol & 127);
        const int a = ncol - FF; return (a >> 7) * 256 + 128 + (a & 127);
    }
    return ncol;
}
DI void transpose_item(const float* W, int K, int N, bf16_t* WT, int ptype, LAS float* scr, int item, int lane) {
    const int nblk = N / 32, kb = item / nblk, nb = item % nblk, k0 = 64 * kb, n0 = 32 * nb;
#pragma unroll 8
    for (int i = 0; i < 32; ++i) { const int kk = 2 * i + (lane >> 5); scr[kk * 33 + (lane & 31)] = W[(size_t)(k0 + kk) * N + n0 + (lane & 31)]; }
    asm volatile("s_waitcnt lgkmcnt(0)" ::: "memory");
    const int c = lane & 7;
#pragma unroll
    for (int j = 0; j < 4; ++j) { const int n = (lane >> 3) + 8 * j; const LAS float* s = scr + (8 * c) * 33 + n;
        u32x4 o; o.x = cvtpk(s[0 * 33], s[1 * 33]); o.y = cvtpk(s[2 * 33], s[3 * 33]); o.z = cvtpk(s[4 * 33], s[5 * 33]); o.w = cvtpk(s[6 * 33], s[7 * 33]);
        *(u32x4*)(WT + (size_t)dest_row(ptype, n0 + n) * K + k0 + 8 * c) = o; }
    asm volatile("s_waitcnt lgkmcnt(0)" ::: "memory");
}
DI float wave_sum(float v) {
#pragma unroll
    for (int o = 1; o < 64; o <<= 1) v += __shfl_xor(v, o);
    return v;
}
DI void sincos_d(float angf, float& s_out, float& c_out) {
    const double ang = (double)angf; const double kq = __builtin_rint(ang * 0.63661977236758134308);
    const double r = __builtin_fma(-kq, 1.57079632679489661923, ang) - kq * 6.123233995736766e-17; const double r2 = r * r;
    double sp = 1.0 / 6227020800.0; sp = sp * r2 - 1.0 / 39916800.0; sp = sp * r2 + 1.0 / 362880.0; sp = sp * r2 - 1.0 / 5040.0; sp = sp * r2 + 1.0 / 120.0; sp = sp * r2 - 1.0 / 6.0; sp = sp * r2 + 1.0; sp = sp * r;
    double cp = 1.0 / 479001600.0; cp = cp * r2 - 1.0 / 3628800.0; cp = cp * r2 + 1.0 / 40320.0; cp = cp * r2 - 1.0 / 720.0; cp = cp * r2 + 1.0 / 24.0; cp = cp * r2 - 0.5; cp = cp * r2 + 1.0;
    const int q = ((int)kq) & 3;
    const double sv = (q == 0) ? sp : (q == 1) ? cp : (q == 2) ? -sp : -cp;
    const double cv = (q == 0) ? cp : (q == 1) ? -sp : (q == 2) ? -cp : sp;
    s_out = (float)sv; c_out = (float)cv;
}

template <bool DO_LN, bool SB>
DI void ln_pass(const void* src, bf16_t* xn, float* stats, const float* lng, const float* lnb, const float* modbase, int which_sh, int Sshift, int gw, int lane) {
    auto ldrow = [&](int m, f32x4 (&d)[4]) {
        if (SB) { const u32x2* xr = (const u32x2*)((const bf16_t*)src + (size_t)m * DM) + lane;
#pragma unroll
            for (int j = 0; j < 4; ++j) { const u32x2 w = xr[64 * j]; d[j] = (f32x4){bf_lo(w.x), bf_hi(w.x), bf_lo(w.y), bf_hi(w.y)}; } }
        else { const f32x4* xr = (const f32x4*)((const float*)src + (size_t)m * DM) + lane;
#pragma unroll
            for (int j = 0; j < 4; ++j) d[j] = __builtin_nontemporal_load(xr + 64 * j); } };
    f32x4 nx[4];
    ldrow(gw, nx);
    for (int m = gw; m < TH; m += 2048) {
        f32x4 v[4];
#pragma unroll
        for (int j = 0; j < 4; ++j) v[j] = nx[j];
        if (m + 2048 < TH) ldrow(m + 2048, nx);
        const int seq = m >> Sshift; const float* sh = modbase + (size_t)seq * 6144 + which_sh * 1024; const float* scp = sh + 1024;
        f32x4 S4[4], H4[4], G4[4], B4[4];
#pragma unroll
        for (int j = 0; j < 4; ++j) { const int col = 4 * lane + 256 * j; S4[j] = *(const f32x4*)(scp + col); H4[j] = *(const f32x4*)(sh + col);
            if (DO_LN) { G4[j] = *(const f32x4*)(lng + col); B4[j] = *(const f32x4*)(lnb + col); } }
        __builtin_amdgcn_sched_barrier(0);
        float mean = 0.f, rstd = 1.f;
        if (DO_LN) {
            float s = 0.f;
#pragma unroll
            for (int j = 0; j < 4; ++j) s += (v[j].x + v[j].y) + (v[j].z + v[j].w);
            mean = wave_sum(s) * (1.f / DM); float s2 = 0.f;
#pragma unroll
            for (int j = 0; j < 4; ++j) { const f32x4 d = v[j] - mean; s2 += (d.x * d.x + d.y * d.y) + (d.z * d.z + d.w * d.w); }
            rstd = 1.0f / sqrtf(wave_sum(s2) * (1.f / DM) + LN_EPS);
            if (lane == 0) { stats[2 * (size_t)m] = mean; stats[2 * (size_t)m + 1] = rstd; }
        }
#pragma unroll
        for (int j = 0; j < 4; ++j) { const int col = 4 * lane + 256 * j; f32x4 xv = v[j];
            if (DO_LN) xv = (xv - mean) * rstd * G4[j] + B4[j];
            const f32x4 hv = xv * (S4[j] + 1.0f) + H4[j];
            u32x2 w; w.x = cvtpk(hv.x, hv.y); w.y = cvtpk(hv.z, hv.w);
            *(u32x2*)(xn + (size_t)m * DM + col) = w; }
    }
}
DI void final_ln(float* io, const float* lng, const float* lnb, int gw, int lane) {
    f32x4 nx[4];
    { const f32x4* xr0 = (const f32x4*)(io + (size_t)gw * DM) + lane;
#pragma unroll
      for (int j = 0; j < 4; ++j) nx[j] = xr0[64 * j]; }
    for (int m = gw; m < TH; m += 2048) {
        f32x4* xr = (f32x4*)(io + (size_t)m * DM) + lane;
        f32x4 v[4];
#pragma unroll
        for (int j = 0; j < 4; ++j) v[j] = nx[j];
        if (m + 2048 < TH) { const f32x4* xn_ = (const f32x4*)(io + (size_t)(m + 2048) * DM) + lane;
#pragma unroll
            for (int j = 0; j < 4; ++j) nx[j] = xn_[64 * j]; }
        f32x4 G4[4], B4[4];
#pragma unroll
        for (int j = 0; j < 4; ++j) { const int col = 4 * lane + 256 * j; G4[j] = *(const f32x4*)(lng + col); B4[j] = *(const f32x4*)(lnb + col); }
        __builtin_amdgcn_sched_barrier(0);
        float s = 0.f;
#pragma unroll
        for (int j = 0; j < 4; ++j) s += (v[j].x + v[j].y) + (v[j].z + v[j].w);
        const float mean = wave_sum(s) * (1.f / DM); float s2 = 0.f;
#pragma unroll
        for (int j = 0; j < 4; ++j) { const f32x4 d = v[j] - mean; s2 += (d.x * d.x + d.y * d.y) + (d.z * d.z + d.w * d.w); }
        const float rstd = 1.0f / sqrtf(wave_sum(s2) * (1.f / DM) + LN_EPS);
#pragma unroll
        for (int j = 0; j < 4; ++j) __builtin_nontemporal_store((v[j] - mean) * rstd * G4[j] + B4[j], xr + 64 * j);
    }
}

DI int crow(int r, int hi) { return (r & 3) + 8 * (r >> 2) + 4 * hi; }
DI int vbyte(int key, int chunk) { return (chunk >> 2) * 4096 + (key >> 4) * 1024 + (key & 15) * 64 + (chunk & 3) * 16; }
DI int kbyte(int key, int chunk) { return chunk * 1024 + (key >> 4) * 256 + (((key + 2 * chunk) & 15) << 4); }
DI float max3f(float a, float b, float c) { float r; asm("v_max3_f32 %0, %1, %2, %3" : "=v"(r) : "v"(a), "v"(b), "v"(c)); return r; }
DI float max2f(float a, float b) { float r; asm("v_max_f32_e32 %0, %1, %2" : "=v"(r) : "v"(a), "v"(b)); return r; }
DI float rowmax32(const f32x16& p0, const f32x16& p1) {
    float a = max3f(p0[0], p0[1], p1[0]), b = max3f(p0[2], p0[3], p1[1]); a = max3f(a, p1[2], p1[3]);
#pragma unroll
    for (int r = 4; r < 16; r += 4) { a = max3f(a, p0[r], p0[r + 1]); b = max3f(b, p0[r + 2], p0[r + 3]); a = max3f(a, p1[r], p1[r + 1]); b = max3f(b, p1[r + 2], p1[r + 3]); }
    return max2f(a, b);
}
DI float xhalf_max(float v) { auto rr = __builtin_amdgcn_permlane32_swap(__float_as_uint(v), __float_as_uint(v), false, false); return max2f(__uint_as_float(rr[0]), __uint_as_float(rr[1])); }
DI float xhalf_sum(float v) { auto rr = __builtin_amdgcn_permlane32_swap(__float_as_uint(v), __float_as_uint(v), false, false); return __uint_as_float(rr[0]) + __uint_as_float(rr[1]); }
typedef short v4i16_t __attribute__((ext_vector_type(4)));
DI s16x4 vtr(LAS const unsigned char* p) { return __builtin_bit_cast(s16x4, __builtin_amdgcn_ds_read_tr16_b64_v4i16((LAS v4i16_t*)p)); }

template <int ND0, int D0OFF>
DI void qk64(f32x16& p0, f32x16& p1, LAS const unsigned char* kslot, const bf16x8* qr, int r32, int hi) {
    bf16x8 kf[2 * ND0];
#pragma unroll
    for (int d0 = 0; d0 < ND0; ++d0) {
        LAS const unsigned char* kp = kslot + kbyte(r32, 2 * (D0OFF + d0) + hi);
        kf[2 * d0] = *(LAS const bf16x8*)kp; kf[2 * d0 + 1] = *(LAS const bf16x8*)(kp + 512);
    }
    __builtin_amdgcn_sched_barrier(0);
    f32x16 a, b;
#pragma unroll
    for (int i = 0; i < 16; ++i) { a[i] = 0.f; b[i] = 0.f; }
#pragma unroll
    for (int d0 = 0; d0 < ND0; ++d0) {
        a = __builtin_amdgcn_mfma_f32_32x32x16_bf16(kf[2 * d0], qr[D0OFF + d0], a, 0, 0, 0);
        b = __builtin_amdgcn_mfma_f32_32x32x16_bf16(kf[2 * d0 + 1], qr[D0OFF + d0], b, 0, 0, 0);
    }
    p0 = a; p1 = b;
}
DI void softmax_pv(f32x16& p0, f32x16& p1, float& m, float& l, f32x16& o0, f32x16& o1, LAS const unsigned char* vslot, int lane, int hi) {
    LAS const unsigned char* vp = vslot + ((lane >> 4) & 1) * 32 + (lane & 3) * 8 + (4 * hi + ((lane & 15) >> 2)) * 64;
    s16x4 vlo0[4], vhi0[4], vlo1[4], vhi1[4];
#pragma unroll
    for (int ks = 0; ks < 4; ++ks) { vlo0[ks] = vtr(vp + ks * 1024); vhi0[ks] = vtr(vp + ks * 1024 + 512); vlo1[ks] = vtr(vp + 4096 + ks * 1024); vhi1[ks] = vtr(vp + 4096 + ks * 1024 + 512); }
    __builtin_amdgcn_sched_barrier(0);
    const float mx = xhalf_max(rowmax32(p0, p1));
    const float mn = max2f(m, mx); const float f = fexp2(m - mn); m = mn;
    float s = 0.f;
#pragma unroll
    for (int r = 0; r < 16; ++r) { p0[r] = fexp2(p0[r] - mn); p1[r] = fexp2(p1[r] - mn); s += p0[r] + p1[r]; }
    s = xhalf_sum(s);
    l = l * f + s;
#pragma unroll
    for (int r = 0; r < 16; ++r) { o0[r] *= f; o1[r] *= f; }
    u32x4 pw[4];
    pw[0] = (u32x4){cvtpk(p0[0], p0[1]), cvtpk(p0[2], p0[3]), cvtpk(p0[4], p0[5]), cvtpk(p0[6], p0[7])};
    pw[1] = (u32x4){cvtpk(p0[8], p0[9]), cvtpk(p0[10], p0[11]), cvtpk(p0[12], p0[13]), cvtpk(p0[14], p0[15])};
    pw[2] = (u32x4){cvtpk(p1[0], p1[1]), cvtpk(p1[2], p1[3]), cvtpk(p1[4], p1[5]), cvtpk(p1[6], p1[7])};
    pw[3] = (u32x4){cvtpk(p1[8], p1[9]), cvtpk(p1[10], p1[11]), cvtpk(p1[12], p1[13]), cvtpk(p1[14], p1[15])};
#pragma unroll
    for (int ks = 0; ks < 4; ++ks) {
        const bf16x8 v0 = (bf16x8){vlo0[ks][0], vlo0[ks][1], vlo0[ks][2], vlo0[ks][3], vhi0[ks][0], vhi0[ks][1], vhi0[ks][2], vhi0[ks][3]};
        const bf16x8 v1 = (bf16x8){vlo1[ks][0], vlo1[ks][1], vlo1[ks][2], vlo1[ks][3], vhi1[ks][0], vhi1[ks][1], vhi1[ks][2], vhi1[ks][3]};
        const bf16x8 pf = __builtin_bit_cast(bf16x8, pw[ks]);
        o0 = __builtin_amdgcn_mfma_f32_32x32x16_bf16(v0, pf, o0, 0, 0, 0);
        o1 = __builtin_amdgcn_mfma_f32_32x32x16_bf16(v1, pf, o1, 0, 0, 0);
    }
}
DI f32x16 zero16() { f32x16 z;
#pragma unroll
    for (int i = 0; i < 16; ++i) z[i] = 0.f;
    return z; }
DI void store_oT(bf16_t* dst_row  , const f32x16& o0, const f32x16& o1, int hi) {
#pragma unroll
    for (int g = 0; g < 4; ++g) {
        u32x2 w0; w0.x = cvtpk(o0[4 * g], o0[4 * g + 1]); w0.y = cvtpk(o0[4 * g + 2], o0[4 * g + 3]);
        u32x2 w1; w1.x = cvtpk(o1[4 * g], o1[4 * g + 1]); w1.y = cvtpk(o1[4 * g + 2], o1[4 * g + 3]);
        *(u32x2*)(dst_row + 8 * g + 4 * hi) = w0; *(u32x2*)(dst_row + 32 + 8 * g + 4 * hi) = w1;
    }
}

constexpr int STG_ROW = 144, STG_BYTES = 5120, STG_OFF = 65536, STG_SC = 4608;
DI void stage_oT(LAS unsigned char* stg, const f32x16& o0, const f32x16& o1, int r32, int hi) {
#pragma unroll
    for (int g = 0; g < 4; ++g) {
        u32x2 w0; w0.x = cvtpk(o0[4 * g], o0[4 * g + 1]); w0.y = cvtpk(o0[4 * g + 2], o0[4 * g + 3]);
        u32x2 w1; w1.x = cvtpk(o1[4 * g], o1[4 * g + 1]); w1.y = cvtpk(o1[4 * g + 2], o1[4 * g + 3]);
        *(LAS u32x2*)(stg + r32 * STG_ROW + (8 * g + 4 * hi) * 2) = w0; *(LAS u32x2*)(stg + r32 * STG_ROW + 64 + (8 * g + 4 * hi) * 2) = w1;
    }
}
DI void flush_rows(LAS const unsigned char* stg, bf16_t* dst0, size_t row_stride, int lane) {
    asm volatile("s_waitcnt lgkmcnt(0)" ::: "memory");
#pragma unroll
    for (int i = 0; i < 4; ++i) { const int pc = i * 64 + lane, row = pc >> 3, ch = pc & 7;
        const u32x4 v = *(LAS const u32x4*)(stg + row * STG_ROW + ch * 16);
        *(u32x4*)(dst0 + (size_t)row * row_stride + ch * 8) = v; }
}

DI void attn_na_unit(int ua, int S, int layer, const bf16_t* PROJ, bf16_t* O, const float* rpb, LAS unsigned char* wl, LAS float* bias, int lane) {
    const int r32 = lane & 31, hi = lane >> 5;
    const int R = S >> 6;
    const int half_c = ua & 1; const int t1 = ua >> 1; const int r = t1 % R; const int t2 = t1 / R; const int head = t2 & 3; const int seq = t2 >> 2;
    const size_t seqrow = (size_t)seq * S;
    const int c = 32 * half_c + r32; const int cs = min(max(c - 8, 0), 48); const int rs = min(max(r - 4, 0), R - 8);
    const bf16_t* Qp = PROJ + (seqrow + (size_t)r * 64 + c) * PQ + head * 64;
    bf16x8 qr[4];
#pragma unroll
    for (int d0 = 0; d0 < 4; ++d0) qr[d0] = *(const bf16x8*)(Qp + 16 * d0 + 8 * hi);
    for (int i = lane; i < 465; i += 64) bias[i] = rpb[(size_t)(layer * 4 + head) * 465 + i] * LOG2E;
    const bf16_t* Kb = PROJ + seqrow * PQ + 256 + head * 64; const bf16_t* Vb = PROJ + seqrow * PQ + 512 + head * 64;
    float m = -1e30f, l = 0.f; f32x16 o0 = zero16(), o1 = zero16();
    u32x4 kreg[8], vreg[8];
    {   const size_t tb = (size_t)rs * 64;
#pragma unroll
        for (int i = 0; i < 8; ++i) { kreg[i] = *(const u32x4*)(Kb + (tb + 8 * i + (lane >> 3)) * PQ + 8 * (lane & 7));
            vreg[i] = *(const u32x4*)(Vb + (tb + 16 * (i & 3) + (lane >> 2)) * PQ + 32 * (i >> 2) + 8 * (lane & 3)); } }
    for (int j = 0; j < 8; ++j) {
        const int kr = rs + j;
#pragma unroll
        for (int i = 0; i < 8; ++i) { *(LAS u32x4*)(wl + kbyte(8 * i + (lane >> 3), lane & 7)) = kreg[i]; *(LAS u32x4*)(wl + 8192 + i * 1024 + lane * 16) = vreg[i]; }
        asm volatile("s_waitcnt lgkmcnt(0)" ::: "memory");
        if (j + 1 < 8) { const size_t tb = (size_t)(kr + 1) * 64;
#pragma unroll
            for (int i = 0; i < 8; ++i) { kreg[i] = *(const u32x4*)(Kb + (tb + 8 * i + (lane >> 3)) * PQ + 8 * (lane & 7));
                vreg[i] = *(const u32x4*)(Vb + (tb + 16 * (i & 3) + (lane >> 2)) * PQ + 32 * (i >> 2) + 8 * (lane & 3)); } }
        f32x16 p0, p1;
        qk64<4, 0>(p0, p1, wl, qr, r32, hi);
        const int dr = kr - r + 7; LAS const float* brow = bias + dr * 31;
#pragma unroll
        for (int rr = 0; rr < 16; ++rr) {
            const int k0 = crow(rr, hi), k1 = k0 + 32;
            const int i0 = min(max(k0 - c + 15, 0), 30), i1 = min(max(k1 - c + 15, 0), 30);
            const float b0 = brow[i0], b1 = brow[i1];
            p0[rr] = (k0 >= cs && k0 < cs + 16) ? p0[rr] + b0 : -INFINITY;
            p1[rr] = (k1 >= cs && k1 < cs + 16) ? p1[rr] + b1 : -INFINITY;
        }
        softmax_pv(p0, p1, m, l, o0, o1, wl + 8192, lane, hi);
        asm volatile("s_waitcnt lgkmcnt(0)" ::: "memory");
    }
    const float inv = 1.0f / l;
#pragma unroll
    for (int i = 0; i < 16; ++i) { o0[i] *= inv; o1[i] *= inv; }
    store_oT(O + (seqrow + (size_t)r * 64 + c) * DM + head * 64, o0, o1, hi);
}

template <int MODE>
DI void attn_dil_unit(int uc, int S, int dsh  , int slot, const bf16_t* PROJ, bf16_t* O, bf16_t* PART, float* ML, LAS unsigned char* wl, int lane) {
    const int r32 = lane & 31, hi = lane >> 5;
    const int upsh = S >> 5;
    const int j = uc % upsh; const int t2 = uc / upsh; const int head = t2 & 7; const int seq = t2 >> 3;
    const int L = S >> dsh; const int bps = L >> 5; const int rho = j / bps; const int a = j % bps;
    const size_t seqrow = (size_t)seq * S;
    const int nq = 32 * a + r32; const size_t qrow = seqrow + ((size_t)nq << dsh) + rho;
    const bf16_t* Qp = PROJ + qrow * PQ + 1536 + head * 64;
    bf16x8 qr[4];
#pragma unroll
    for (int d0 = 0; d0 < 4; ++d0) qr[d0] = *(const bf16x8*)(Qp + 16 * d0 + 8 * hi);
    const bf16_t* Kb = PROJ + seqrow * PQ + 2048 + head * 64; const bf16_t* Vb = PROJ + seqrow * PQ + 2560 + head * 64;
    float m = -1e30f, l = 0.f; f32x16 o0 = zero16(), o1 = zero16();
    u32x4 kreg[8], vreg[8];
#define DIL_LOAD(n0_) do { \
        _Pragma("unroll") for (int i = 0; i < 8; ++i) { const int nk_ = min(max((n0_) + 8 * i + (lane >> 3), 0), L - 1); \
            kreg[i] = *(const u32x4*)(Kb + (((size_t)nk_ << dsh) + rho) * PQ + 8 * (lane & 7)); \
            const int nv_ = min(max((n0_) + 16 * (i & 3) + (lane >> 2), 0), L - 1); \
            vreg[i] = *(const u32x4*)(Vb + (((size_t)nv_ << dsh) + rho) * PQ + 32 * (i >> 2) + 8 * (lane & 3)); } } while (0)
    DIL_LOAD(32 * a - 64);
    for (int t = 0; t < 3; ++t) {
        const int n0 = 32 * a - 64 + 64 * t;
#pragma unroll
        for (int i = 0; i < 8; ++i) { *(LAS u32x4*)(wl + kbyte(8 * i + (lane >> 3), lane & 7)) = kreg[i]; *(LAS u32x4*)(wl + 8192 + i * 1024 + lane * 16) = vreg[i]; }
        asm volatile("s_waitcnt lgkmcnt(0)" ::: "memory");
        if (t + 1 < 3) DIL_LOAD(n0 + 64);
        f32x16 p0, p1;
        qk64<4, 0>(p0, p1, wl, qr, r32, hi);
#pragma unroll
        for (int rr = 0; rr < 16; ++rr) {
            const int k0 = n0 + crow(rr, hi), k1 = k0 + 32;
            const int d0 = nq - k0, d1 = nq - k1;
            p0[rr] = (d0 <= 64 && d0 >= -64 && k0 >= 0 && k0 < L) ? p0[rr] : -INFINITY;
            p1[rr] = (d1 <= 64 && d1 >= -64 && k1 >= 0 && k1 < L) ? p1[rr] : -INFINITY;
        }
        softmax_pv(p0, p1, m, l, o0, o1, wl + 8192, lane, hi);
        asm volatile("s_waitcnt lgkmcnt(0)" ::: "memory");
    }
#undef DIL_LOAD
    if (MODE == 0) {
        const float inv = 1.0f / l;
#pragma unroll
        for (int i = 0; i < 16; ++i) { o0[i] *= inv; o1[i] *= inv; }
        store_oT(PART + (((size_t)slot * TH + qrow) * 8 + head) * 64, o0, o1, hi);
        if (hi == 0) { f32x2 ml = {m, l}; *(f32x2*)(ML + (((size_t)slot * TH + qrow) * 8 + head) * 2) = ml; }
    } else {
        const f32x2 ml4 = *(const f32x2*)(ML + (((size_t)0 * TH + qrow) * 8 + head) * 2);
        const f32x2 ml16 = *(const f32x2*)(ML + (((size_t)1 * TH + qrow) * 8 + head) * 2);
        const float mall = fmaxf(m, fmaxf(ml4.x, ml16.x));
        const float w1 = fexp2(m - mall), w4 = fexp2(ml4.x - mall) * ml4.y, w16 = fexp2(ml16.x - mall) * ml16.y;
        const float inv = 1.0f / (w1 * l + w4 + w16);
        const bf16_t* P4 = PART + (((size_t)0 * TH + qrow) * 8 + head) * 64; const bf16_t* P16 = PART + (((size_t)1 * TH + qrow) * 8 + head) * 64;
#pragma unroll
        for (int g = 0; g < 4; ++g) {
            const u32x2 a0 = *(const u32x2*)(P4 + 8 * g + 4 * hi), a1 = *(const u32x2*)(P4 + 32 + 8 * g + 4 * hi);
            const u32x2 b0 = *(const u32x2*)(P16 + 8 * g + 4 * hi), b1 = *(const u32x2*)(P16 + 32 + 8 * g + 4 * hi);
            o0[4 * g + 0] = (w1 * o0[4 * g + 0] + w4 * bf_lo(a0.x) + w16 * bf_lo(b0.x)) * inv; o0[4 * g + 1] = (w1 * o0[4 * g + 1] + w4 * bf_hi(a0.x) + w16 * bf_hi(b0.x)) * inv;
            o0[4 * g + 2] = (w1 * o0[4 * g + 2] + w4 * bf_lo(a0.y) + w16 * bf_lo(b0.y)) * inv; o0[4 * g + 3] = (w1 * o0[4 * g + 3] + w4 * bf_hi(a0.y) + w16 * bf_hi(b0.y)) * inv;
            o1[4 * g + 0] = (w1 * o1[4 * g + 0] + w4 * bf_lo(a1.x) + w16 * bf_lo(b1.x)) * inv; o1[4 * g + 1] = (w1 * o1[4 * g + 1] + w4 * bf_hi(a1.x) + w16 * bf_hi(b1.x)) * inv;
            o1[4 * g + 2] = (w1 * o1[4 * g + 2] + w4 * bf_lo(a1.y) + w16 * bf_lo(b1.y)) * inv; o1[4 * g + 3] = (w1 * o1[4 * g + 3] + w4 * bf_hi(a1.y) + w16 * bf_hi(b1.y)) * inv;
        }
        store_oT(O + qrow * DM + 512 + head * 64, o0, o1, hi);
    }
}

#define WALK_LOADS(KR_, VR_, KROW_, VROW_) do { \
        _Pragma("unroll") for (int e = 0; e < 2; ++e) { const int i_ = 2 * w4 + e; \
            KR_[e] = *(const u32x4*)(Kb_ + (size_t)(KROW_(8 * i_ + (lane >> 3))) * PQ + 8 * (lane & 7)); \
            VR_[e] = *(const u32x4*)(Vb_ + (size_t)(VROW_(8 * i_ + (lane >> 3))) * PQ + 8 * (lane & 7)); } } while (0)
#define WALK_STORES(KR_, VR_, dst_) do { \
        _Pragma("unroll") for (int e = 0; e < 2; ++e) { const int i_ = 2 * w4 + e; \
            *(LAS u32x4*)((dst_) + kbyte(8 * i_ + (lane >> 3), lane & 7)) = KR_[e]; *(LAS u32x4*)((dst_) + 8192 + vbyte(8 * i_ + (lane >> 3), lane & 7)) = VR_[e]; } } while (0)

template <int MODE>
DI void walk_dil(int Ssh, int nseq, int dsh, int slot, const bf16_t* PROJ, bf16_t* O, bf16_t* PART, float* ML, LAS unsigned char* lds, int wid, int lane, int wgi) {
    constexpr int NW = 512; const int S = 1 << Ssh;
    const int r32 = lane & 31, hi = lane >> 5, g = wid >> 2, w4 = g ? 3 - (wid & 3) : (wid & 3);
    LAS unsigned char* wb = lds + g * 32768;
    const int L = S >> dsh, ush = Ssh - 7, bsh = Ssh - dsh - 7;
    const int F = ((nseq * 8) << ush) / NW * 4;
    u32x4 kA[2], vA[2], kB[2], vB[2]; bf16x8 qr[4], qn[4];
    float m = -1e30f, l = 0.f; f32x16 o0 = zero16(), o1 = zero16();
    int c_head = 0, c_rho = 0, c_A = 0; size_t c_seqrow = 0;
    f32x2 pml4 = {0.f, 0.f}, pml16 = {0.f, 0.f};
#define DIL_DECODE(u_, head_, rho_, A_, seqrow_) do { const int j_ = (u_) & ((1 << ush) - 1); const int t2_ = (u_) >> ush; head_ = t2_ & 7; seqrow_ = (size_t)(t2_ >> 3) << Ssh; rho_ = j_ >> bsh; A_ = j_ & ((1 << bsh) - 1); } while (0)
#define DIL_TILE_LOAD(KR_, VR_, f_) do { const int u_ = wgi + ((f_) >> 2) * NW; int h_, rho_, A_; size_t sr_; DIL_DECODE(u_, h_, rho_, A_, sr_); \
        const bf16_t* Kb_ = PROJ + sr_ * PQ + 2048 + h_ * 64; const bf16_t* Vb_ = PROJ + sr_ * PQ + 2560 + h_ * 64; const int n0_ = 128 * A_ - 64 + 64 * ((f_) & 3); \
        auto rowf = [&](int k_) { return (((size_t)min(max(n0_ + k_, 0), L - 1)) << dsh) + rho_; }; \
        WALK_LOADS(KR_, VR_, rowf, rowf); } while (0)
#define DIL_Q_LOAD(dst_, u_) do { int h_, rho_, A_; size_t sr_; DIL_DECODE(u_, h_, rho_, A_, sr_); \
        const bf16_t* Qp_ = PROJ + (sr_ + (((size_t)(128 * A_ + 32 * w4 + r32)) << dsh) + rho_) * PQ + 1536 + h_ * 64; \
        _Pragma("unroll") for (int d0 = 0; d0 < 4; ++d0) dst_[d0] = *(const bf16x8*)(Qp_ + 16 * d0 + 8 * hi); } while (0)
    DIL_TILE_LOAD(kA, vA, 0); DIL_Q_LOAD(qr, wgi);
    WALK_STORES(kA, vA, wb);
    DIL_TILE_LOAD(kB, vB, 1);
    lds_barrier();
    auto body = [&](const int f, LAS unsigned char* cur) {
        const int s = f & 3;
        if (s == 0) { DIL_DECODE(wgi + (f >> 2) * NW, c_head, c_rho, c_A, c_seqrow); m = -1e30f; l = 0.f; o0 = zero16(); o1 = zero16();
            if (MODE == 1) { const size_t qrow_ = c_seqrow + (size_t)(128 * c_A + 32 * w4 + r32);
                pml4 = *(const f32x2*)(ML + (((size_t)0 * TH + qrow_) * 8 + c_head) * 2); pml16 = *(const f32x2*)(ML + (((size_t)1 * TH + qrow_) * 8 + c_head) * 2); } }
        if (s == 1 && f + 3 < F) DIL_Q_LOAD(qn, wgi + ((f + 3) >> 2) * NW);
        const int nq = 128 * c_A + 32 * w4 + r32;
        if (s >= (w4 >> 1) && s <= (w4 >> 1) + 2) {
            const int n0 = 128 * c_A - 64 + 64 * s;
            f32x16 p0, p1;
            qk64<4, 0>(p0, p1, cur, qr, r32, hi);
            const int nq0 = 128 * c_A + 32 * w4;
            const bool allvalid = (n0 >= 0) && (n0 + 63 < L) && (nq0 + 31 - n0 <= 64) && (n0 + 63 - nq0 <= 64);
            if (!allvalid) {
                const int lo = max(nq - 64, 0), hb = min(nq + 64, L - 1);
                const unsigned ub = (unsigned)(n0 + 4 * hi - lo), wv = (unsigned)(hb - lo);
#pragma unroll
                for (int rr = 0; rr < 16; ++rr) {
                    const unsigned c0 = (unsigned)((rr & 3) + 8 * (rr >> 2));
                    p0[rr] = (ub + c0 <= wv) ? p0[rr] : -INFINITY;
                    p1[rr] = (ub + c0 + 32u <= wv) ? p1[rr] : -INFINITY;
                }
            }
            softmax_pv(p0, p1, m, l, o0, o1, cur + 8192, lane, hi);
        }
        if (s == 3) {
            const size_t qrow = c_seqrow + (((size_t)nq) << dsh) + c_rho; const int head = c_head;
            const size_t qrow0 = c_seqrow + (((size_t)(128 * c_A + 32 * w4)) << dsh) + c_rho;
            LAS unsigned char* stg = lds + STG_OFF + wid * STG_BYTES;
            if (MODE == 0) {
                const float inv = 1.0f / l;
#pragma unroll
                for (int i = 0; i < 16; ++i) { o0[i] *= inv; o1[i] *= inv; }
                stage_oT(stg, o0, o1, r32, hi);
                flush_rows(stg, PART + (((size_t)slot * TH + qrow0) * 8 + head) * 64, (size_t)512 << dsh, lane);
                if (hi == 0) { f32x2 ml = {m, l}; *(f32x2*)(ML + (((size_t)slot * TH + qrow) * 8 + head) * 2) = ml; }
            } else {
                const f32x2 ml4 = pml4, ml16 = pml16;
                const float mall = fmaxf(m, fmaxf(ml4.x, ml16.x));
                const float w1 = fexp2(m - mall), w4_ = fexp2(ml4.x - mall) * ml4.y, w16 = fexp2(ml16.x - mall) * ml16.y;
                const float inv = 1.0f / (w1 * l + w4_ + w16);
                const float s1 = w1 * inv;
#pragma unroll
                for (int i = 0; i < 16; ++i) { o0[i] *= s1; o1[i] *= s1; }
                stage_oT(stg, o0, o1, r32, hi);
                if (hi == 0) { f32x2 sc = {w4_ * inv, w16 * inv}; *(LAS f32x2*)(stg + STG_SC + r32 * 8) = sc; }
                asm volatile("s_waitcnt lgkmcnt(0)" ::: "memory");
                const bf16_t* P4 = PART + (((size_t)0 * TH + qrow0) * 8 + head) * 64; const bf16_t* P16 = PART + (((size_t)1 * TH + qrow0) * 8 + head) * 64;
                bf16_t* Od = O + qrow0 * DM + 512 + head * 64;
#pragma unroll
                for (int i = 0; i < 4; ++i) { const int pc = i * 64 + lane, row = pc >> 3, ch = pc & 7;
                    const u32x4 own = *(LAS const u32x4*)(stg + row * STG_ROW + ch * 16);
                    const f32x2 sc = *(LAS const f32x2*)(stg + STG_SC + row * 8);
                    const u32x4 a = *(const u32x4*)(P4 + (size_t)row * 512 + ch * 8), b = *(const u32x4*)(P16 + (size_t)row * 512 + ch * 8);
                    u32x4 r;
                    r.x = cvtpk(bf_lo(own.x) + sc.x * bf_lo(a.x) + sc.y * bf_lo(b.x), bf_hi(own.x) + sc.x * bf_hi(a.x) + sc.y * bf_hi(b.x));
                    r.y = cvtpk(bf_lo(own.y) + sc.x * bf_lo(a.y) + sc.y * bf_lo(b.y), bf_hi(own.y) + sc.x * bf_hi(a.y) + sc.y * bf_hi(b.y));
                    r.z = cvtpk(bf_lo(own.z) + sc.x * bf_lo(a.z) + sc.y * bf_lo(b.z), bf_hi(own.z) + sc.x * bf_hi(a.z) + sc.y * bf_hi(b.z));
                    r.w = cvtpk(bf_lo(own.w) + sc.x * bf_lo(a.w) + sc.y * bf_lo(b.w), bf_hi(own.w) + sc.x * bf_hi(a.w) + sc.y * bf_hi(b.w));
                    *(u32x4*)(Od + (size_t)row * DM + ch * 8) = r; }
            }
#pragma unroll
            for (int d0 = 0; d0 < 4; ++d0) qr[d0] = qn[d0];
        }
    };
    for (int f = 0; f < F; f += 2) {
        if (f + 2 < F) DIL_TILE_LOAD(kA, vA, f + 2);
        body(f, wb);
        WALK_STORES(kB, vB, wb + 16384);
        lds_barrier();
        if (f + 3 < F) DIL_TILE_LOAD(kB, vB, f + 3);
        body(f + 1, wb + 16384);
        if (f + 2 < F) WALK_STORES(kA, vA, wb);
        lds_barrier();
    }
#undef DIL_DECODE
#undef DIL_TILE_LOAD
#undef DIL_Q_LOAD
}

DI void walk_na(int Ssh, int nseq, int layer, const bf16_t* PROJ, bf16_t* O, const float* rpb, LAS unsigned char* lds, LAS float* bias, int wid, int lane, int wgi) {
    constexpr int NW = 512; const int S = 1 << Ssh;
    const int r32 = lane & 31, hi = lane >> 5, g = wid >> 2, w4 = g ? 3 - (wid & 3) : (wid & 3);
    LAS unsigned char* wb = lds + g * 32768;
    const int R = S >> 6, rsh = Ssh - 7;
    const int F = ((nseq * 4) << rsh) / NW * 9;
    u32x4 kA[2], vA[2], kB[2], vB[2]; bf16x8 qr[4], qn[4];
    float m = -1e30f, l = 0.f; f32x16 o0 = zero16(), o1 = zero16();
    int c_head = 0, c_r0 = 0, bias_head = -1; size_t c_seqrow = 0;
    const int half_c = w4 & 1; const int c = 32 * half_c + r32; const int cs = min(max(c - 8, 0), 48);
#define NA_DECODE(u_, head_, r0_, seqrow_) do { const int rp_ = (u_) & ((1 << rsh) - 1); const int t2_ = (u_) >> rsh; head_ = t2_ & 3; seqrow_ = (size_t)(t2_ >> 2) << Ssh; r0_ = 2 * rp_; } while (0)
#define NA_TILE_LOAD(KR_, VR_, f_) do { const int u_ = wgi + ((f_) / 9) * NW; int h_, r0_; size_t sr_; NA_DECODE(u_, h_, r0_, sr_); \
        const int kr_ = min(min(max(r0_ - 4, 0), R - 8) + (f_) % 9, R - 1); \
        const bf16_t* Kb_ = PROJ + (sr_ + (size_t)kr_ * 64) * PQ + 256 + h_ * 64; const bf16_t* Vb_ = PROJ + (sr_ + (size_t)kr_ * 64) * PQ + 512 + h_ * 64; \
        auto rowf = [&](int k_) { return k_; }; \
        WALK_LOADS(KR_, VR_, rowf, rowf); } while (0)
#define NA_Q_LOAD(dst_, u_) do { int h_, r0_; size_t sr_; NA_DECODE(u_, h_, r0_, sr_); \
        const bf16_t* Qp_ = PROJ + (sr_ + (size_t)(r0_ + (w4 >> 1)) * 64 + c) * PQ + h_ * 64; \
        _Pragma("unroll") for (int d0 = 0; d0 < 4; ++d0) dst_[d0] = *(const bf16x8*)(Qp_ + 16 * d0 + 8 * hi); } while (0)
    NA_TILE_LOAD(kA, vA, 0); NA_Q_LOAD(qr, wgi);
    WALK_STORES(kA, vA, wb);
    NA_TILE_LOAD(kB, vB, 1);
    lds_barrier();
    auto body = [&](const int f, LAS unsigned char* cur) {
        const int s = f % 9;
        if (s == 0) { NA_DECODE(wgi + (f / 9) * NW, c_head, c_r0, c_seqrow); m = -1e30f; l = 0.f; o0 = zero16(); o1 = zero16();
            if (c_head != bias_head) {
                for (int i = lane; i < 465; i += 64) bias[i] = rpb[(size_t)(layer * 4 + c_head) * 465 + i] * LOG2E;
                asm volatile("s_waitcnt lgkmcnt(0)" ::: "memory"); bias_head = c_head; } }
        if (s == 5 && f + 4 < F) NA_Q_LOAD(qn, wgi + ((f + 4) / 9) * NW);
        const int r = c_r0 + (w4 >> 1); const int rs = min(max(r - 4, 0), R - 8); const int kr = min(max(c_r0 - 4, 0), R - 8) + s;
        if (kr >= rs && kr < rs + 8) {
            f32x16 p0, p1;
            qk64<4, 0>(p0, p1, cur, qr, r32, hi);
            const int dr = kr - r + 7;
            LAS const float* bp = bias + dr * 31 + (15 - c + 4 * hi);
            const unsigned ub = (unsigned)(4 * hi - cs);
#pragma unroll
            for (int rr = 0; rr < 16; ++rr) {
                const int c0 = (rr & 3) + 8 * (rr >> 2);
                const float b0 = bp[c0], b1 = bp[c0 + 32];
                p0[rr] = (ub + (unsigned)c0 < 16u) ? p0[rr] + b0 : -INFINITY;
                p1[rr] = (ub + (unsigned)c0 + 32u < 16u) ? p1[rr] + b1 : -INFINITY;
            }
            softmax_pv(p0, p1, m, l, o0, o1, cur + 8192, lane, hi);
        }
        if (s == 8) {
            const float inv = 1.0f / l;
#pragma unroll
            for (int i = 0; i < 16; ++i) { o0[i] *= inv; o1[i] *= inv; }
            LAS unsigned char* stg = lds + STG_OFF + wid * STG_BYTES;
            stage_oT(stg, o0, o1, r32, hi);
            flush_rows(stg, O + (c_seqrow + (size_t)r * 64 + 32 * half_c) * DM + c_head * 64, (size_t)DM, lane);
#pragma unroll
            for (int d0 = 0; d0 < 4; ++d0) qr[d0] = qn[d0];
        }
    };
    for (int f = 0; f < F; f += 2) {
        if (f + 2 < F) NA_TILE_LOAD(kA, vA, f + 2);
        body(f, wb);
        WALK_STORES(kB, vB, wb + 16384);
        lds_barrier();
        if (f + 3 < F) NA_TILE_LOAD(kB, vB, f + 3);
        body(f + 1, wb + 16384);
        if (f + 2 < F) WALK_STORES(kA, vA, wb);
        lds_barrier();
    }
#undef NA_DECODE
#undef NA_TILE_LOAD
#undef NA_Q_LOAD
}

template <int D0OFF>
DI void qk64n(f32x16& p0, f32x16& p1, LAS const unsigned char* kslot, const bf16x8* qr, const f32x16& neg, int r32, int hi) {
    LAS const unsigned char* kpa = kslot + kbyte(r32, 2 * D0OFF + hi); LAS const unsigned char* kpb = kslot + kbyte(r32, 2 * D0OFF + 2 + hi);
    const bf16x8 k00 = *(LAS const bf16x8*)kpa, k01 = *(LAS const bf16x8*)(kpa + 512), k10 = *(LAS const bf16x8*)kpb, k11 = *(LAS const bf16x8*)(kpb + 512);
    f32x16 a = __builtin_amdgcn_mfma_f32_32x32x16_bf16(k00, qr[D0OFF], neg, 0, 0, 0);
    f32x16 b = __builtin_amdgcn_mfma_f32_32x32x16_bf16(k01, qr[D0OFF], neg, 0, 0, 0);
    p0 = __builtin_amdgcn_mfma_f32_32x32x16_bf16(k10, qr[D0OFF + 1], a, 0, 0, 0);
    p1 = __builtin_amdgcn_mfma_f32_32x32x16_bf16(k11, qr[D0OFF + 1], b, 0, 0, 0);
}
DI void softmax_lazy(f32x16& p0, f32x16& p1, float& m, float& l, f32x16& o0, f32x16& o1, u32x4 (&pw)[4], bool first) {
    const float mx = xhalf_max(rowmax32(p0, p1));
    if (first || __any(mx > m + 8.0f)) {
        const float mn = first ? mx : max2f(m, mx);
        const float f = fexp2(m - mn); m = mn; l *= f;
#pragma unroll
        for (int r = 0; r < 16; ++r) { o0[r] *= f; o1[r] *= f; }
    }
    float s0 = 0.f, s1 = 0.f;
#pragma unroll
    for (int r = 0; r < 16; ++r) { p0[r] = fexp2(p0[r] - m); p1[r] = fexp2(p1[r] - m); s0 += p0[r]; s1 += p1[r]; }
    l += xhalf_sum(s0 + s1);
    pw[0] = (u32x4){cvtpk(p0[0], p0[1]), cvtpk(p0[2], p0[3]), cvtpk(p0[4], p0[5]), cvtpk(p0[6], p0[7])};
    pw[1] = (u32x4){cvtpk(p0[8], p0[9]), cvtpk(p0[10], p0[11]), cvtpk(p0[12], p0[13]), cvtpk(p0[14], p0[15])};
    pw[2] = (u32x4){cvtpk(p1[0], p1[1]), cvtpk(p1[2], p1[3]), cvtpk(p1[4], p1[5]), cvtpk(p1[6], p1[7])};
    pw[3] = (u32x4){cvtpk(p1[8], p1[9]), cvtpk(p1[10], p1[11]), cvtpk(p1[12], p1[13]), cvtpk(p1[14], p1[15])};
}
DI void attn_diff_unit(int ub, int Ssh, float lam, float post, const float* subg, const bf16_t* PROJ, bf16_t* O, LAS unsigned char* lds, int wid, int lane) {
    const int r32 = lane & 31, hi = lane >> 5;
    const int S = 1 << Ssh; const int qb = ub & ((1 << (Ssh - 8)) - 1); const int t2 = ub >> (Ssh - 8); const int head = t2 & 3; const int seq = t2 >> 2;
    const size_t seqrow = (size_t)seq << Ssh;
    const size_t qrow = seqrow + (size_t)qb * 256 + wid * 32 + r32;
    const bf16_t* Qp = PROJ + qrow * PQ + 768 + head * 64;
    bf16x8 qr[4];
#pragma unroll
    for (int d0 = 0; d0 < 4; ++d0) qr[d0] = *(const bf16x8*)(Qp + 16 * d0 + 8 * hi);
    const bf16_t* Kb = PROJ + seqrow * PQ + 1024 + head * 64; const bf16_t* Vb = PROJ + seqrow * PQ + 1280 + head * 64;
    const bf16_t* ksrc = Kb + (size_t)(8 * wid + (lane >> 3)) * PQ + 8 * (lane & 7);
    const bf16_t* vsrc = Vb + (size_t)(8 * wid + (lane >> 3)) * PQ + 8 * (lane & 7);
    const int kdst = kbyte(8 * wid + (lane >> 3), lane & 7), vdst = 8192 + vbyte(8 * wid + (lane >> 3), lane & 7);
    const int NT = S >> 6;
    float mA = 0.f, mB = 0.f, lA = 0.f, lB = 0.f; f32x16 a0 = zero16(), a1 = zero16(), b0 = zero16(), b1 = zero16();
    u32x4 kA = *(const u32x4*)ksrc, vA = *(const u32x4*)vsrc;
    *(LAS u32x4*)(lds + kdst) = kA; *(LAS u32x4*)(lds + vdst) = vA;
    __syncthreads();
    const int vlane = ((lane >> 4) & 1) * 32 + (lane & 3) * 8 + (4 * hi + ((lane & 15) >> 2)) * 64;
    auto tile = [&](const int t, LAS unsigned char* cur) {
        f32x16 pa0, pa1, pb0, pb1; u32x4 pwA[4], pwB[4];
        qk64<2, 0>(pa0, pa1, cur, qr, r32, hi);
        qk64<2, 2>(pb0, pb1, cur, qr, r32, hi);
        const float mxA = xhalf_max(rowmax32(pa0, pa1)), mxB = xhalf_max(rowmax32(pb0, pb1));
        if (t == 0 || __any(mxA > mA + 8.0f || mxB > mB + 8.0f)) {
            const float nA = (t == 0) ? mxA : max2f(mA, mxA), nB = (t == 0) ? mxB : max2f(mB, mxB);
            const float fA = fexp2(mA - nA), fB = fexp2(mB - nB); mA = nA; mB = nB; lA *= fA; lB *= fB;
#pragma unroll
            for (int r = 0; r < 16; ++r) { a0[r] *= fA; a1[r] *= fA; b0[r] *= fB; b1[r] *= fB; }
        }
        float sA = 0.f, sB = 0.f;
#pragma unroll
        for (int r = 0; r < 16; ++r) { pa0[r] = fexp2(pa0[r] - mA); pa1[r] = fexp2(pa1[r] - mA); sA += pa0[r] + pa1[r]; }
        pwA[0] = (u32x4){cvtpk(pa0[0], pa0[1]), cvtpk(pa0[2], pa0[3]), cvtpk(pa0[4], pa0[5]), cvtpk(pa0[6], pa0[7])};
        pwA[1] = (u32x4){cvtpk(pa0[8], pa0[9]), cvtpk(pa0[10], pa0[11]), cvtpk(pa0[12], pa0[13]), cvtpk(pa0[14], pa0[15])};
        pwA[2] = (u32x4){cvtpk(pa1[0], pa1[1]), cvtpk(pa1[2], pa1[3]), cvtpk(pa1[4], pa1[5]), cvtpk(pa1[6], pa1[7])};
        pwA[3] = (u32x4){cvtpk(pa1[8], pa1[9]), cvtpk(pa1[10], pa1[11]), cvtpk(pa1[12], pa1[13]), cvtpk(pa1[14], pa1[15])};
        LAS const unsigned char* vp = cur + 8192 + vlane;
#pragma unroll
        for (int ks = 0; ks < 4; ++ks) {
            const s16x4 lo0 = vtr(vp + ks * 1024), hi0 = vtr(vp + ks * 1024 + 512), lo1 = vtr(vp + 4096 + ks * 1024), hi1 = vtr(vp + 4096 + ks * 1024 + 512);
            const bf16x8 v0 = (bf16x8){lo0[0], lo0[1], lo0[2], lo0[3], hi0[0], hi0[1], hi0[2], hi0[3]};
            const bf16x8 v1 = (bf16x8){lo1[0], lo1[1], lo1[2], lo1[3], hi1[0], hi1[1], hi1[2], hi1[3]};
            const bf16x8 pa = __builtin_bit_cast(bf16x8, pwA[ks]);
            a0 = __builtin_amdgcn_mfma_f32_32x32x16_bf16(v0, pa, a0, 0, 0, 0);
            a1 = __builtin_amdgcn_mfma_f32_32x32x16_bf16(v1, pa, a1, 0, 0, 0);
#pragma unroll
            for (int r = 4 * ks; r < 4 * ks + 4; ++r) { pb0[r] = fexp2(pb0[r] - mB); pb1[r] = fexp2(pb1[r] - mB); sB += pb0[r] + pb1[r]; }
        }
        lA += xhalf_sum(sA); lB += xhalf_sum(sB);
        pwB[0] = (u32x4){cvtpk(pb0[0], pb0[1]), cvtpk(pb0[2], pb0[3]), cvtpk(pb0[4], pb0[5]), cvtpk(pb0[6], pb0[7])};
        pwB[1] = (u32x4){cvtpk(pb0[8], pb0[9]), cvtpk(pb0[10], pb0[11]), cvtpk(pb0[12], pb0[13]), cvtpk(pb0[14], pb0[15])};
        pwB[2] = (u32x4){cvtpk(pb1[0], pb1[1]), cvtpk(pb1[2], pb1[3]), cvtpk(pb1[4], pb1[5]), cvtpk(pb1[6], pb1[7])};
        pwB[3] = (u32x4){cvtpk(pb1[8], pb1[9]), cvtpk(pb1[10], pb1[11]), cvtpk(pb1[12], pb1[13]), cvtpk(pb1[14], pb1[15])};
#pragma unroll
        for (int ks = 0; ks < 4; ++ks) {
            const s16x4 lo0 = vtr(vp + ks * 1024), hi0 = vtr(vp + ks * 1024 + 512), lo1 = vtr(vp + 4096 + ks * 1024), hi1 = vtr(vp + 4096 + ks * 1024 + 512);
            const bf16x8 v0 = (bf16x8){lo0[0], lo0[1], lo0[2], lo0[3], hi0[0], hi0[1], hi0[2], hi0[3]};
            const bf16x8 v1 = (bf16x8){lo1[0], lo1[1], lo1[2], lo1[3], hi1[0], hi1[1], hi1[2], hi1[3]};
            const bf16x8 pb = __builtin_bit_cast(bf16x8, pwB[ks]);
            b0 = __builtin_amdgcn_mfma_f32_32x32x16_bf16(v0, pb, b0, 0, 0, 0);
            b1 = __builtin_amdgcn_mfma_f32_32x32x16_bf16(v1, pb, b1, 0, 0, 0);
        }
    };
    for (int t = 0; t < NT; ++t) {
        LAS unsigned char* cur = lds + (t & 1) * 16384; LAS unsigned char* nxt = lds + ((t + 1) & 1) * 16384;
        if (t + 1 < NT) { kA = *(const u32x4*)(ksrc + (size_t)(t + 1) * 64 * PQ); vA = *(const u32x4*)(vsrc + (size_t)(t + 1) * 64 * PQ); }
        tile(t, cur);
        if (t + 1 < NT) { *(LAS u32x4*)(nxt + kdst) = kA; *(LAS u32x4*)(nxt + vdst) = vA; }
        __syncthreads();
    }
    const float ia = 1.0f / lA, ib = lam / lB; float ss = 0.f;
#pragma unroll
    for (int i = 0; i < 16; ++i) { a0[i] = a0[i] * ia - b0[i] * ib; a1[i] = a1[i] * ia - b1[i] * ib; ss += a0[i] * a0[i] + a1[i] * a1[i]; }
    ss = xhalf_sum(ss);
    const float rms = 1.0f / sqrtf(ss * (1.0f / 64.0f) + LN_EPS) * post;
#pragma unroll
    for (int g = 0; g < 4; ++g) { const f32x4 g0 = *(const f32x4*)(subg + 8 * g + 4 * hi), g1 = *(const f32x4*)(subg + 32 + 8 * g + 4 * hi);
#pragma unroll
        for (int jj = 0; jj < 4; ++jj) { a0[4 * g + jj] *= rms * g0[jj]; a1[4 * g + jj] *= rms * g1[jj]; } }
    store_oT(O + qrow * DM + 256 + head * 64, a0, a1, hi);
}


#define XB_TMO      128
#define XB_XCNT(j)  (256  + 64 * (j))
#define XB_XSUB(j)  (1280 + 64 * (j))
#define XB_XGEN(j)  (2304 + 64 * (j))
#define XB_TOP      3328
#define XB_TOPGEN   3392
#define XCD_BAR_WORDS 3456
#define XB_SPIN_CAP (1u << 18)
DI unsigned xb_ld(unsigned* p)              { return __hip_atomic_load(p, __ATOMIC_RELAXED, __HIP_MEMORY_SCOPE_AGENT); }
DI unsigned xb_add(unsigned* p, unsigned v) { return __hip_atomic_fetch_add(p, v, __ATOMIC_RELAXED, __HIP_MEMORY_SCOPE_AGENT); }
DI unsigned xb_xcc_id() { return (unsigned)__builtin_amdgcn_s_getreg((3 << 11) | 20) & 0xFu; }
#define XB_SPIN(cond, bar) do { unsigned _sp = 0; while (cond) { __builtin_amdgcn_s_sleep(1); \
    if ((++_sp & 255u) == 0u) { if (xb_ld(&(bar)[XB_TMO])) break; if (_sp > XB_SPIN_CAP) { atomicAdd(&(bar)[XB_TMO], 1u); break; } } } } while (0)
struct XcdBarrier { unsigned* bar; unsigned x; volatile LAS unsigned* st; int wid; };
DI XcdBarrier xcd_barrier_post(unsigned* bar, volatile LAS unsigned* st, int wid) {
    XcdBarrier b; b.bar = bar; b.x = xb_xcc_id(); b.st = st; b.wid = wid;
    if (wid == 0 && lane_now() == 0) (void)xb_add(&bar[XB_XCNT(b.x)], 1u);
    return b;
}
DI void xcd_barrier_complete(unsigned* bar, unsigned x, unsigned& nloc, unsigned& nx) {
    const unsigned G = gridDim.x * gridDim.y * gridDim.z;
    unsigned sum, cnt, mine, sp = 0u;
    for (;;) {
        sum = 0u; cnt = 0u; mine = 0u;
#pragma unroll
        for (unsigned j = 0; j < 16; ++j) { const unsigned c = xb_ld(&bar[XB_XCNT(j)]); sum += c; cnt += (c > 0u) ? 1u : 0u; mine = (j == x) ? c : mine; }
        if (sum == G) break;
        __builtin_amdgcn_s_sleep(1);
        if ((++sp & 255u) == 0u) { if (xb_ld(&bar[XB_TMO])) break; if (sp > XB_SPIN_CAP) { atomicAdd(&bar[XB_TMO], 1u); break; } }
    }
    nloc = mine > 0u ? mine : 1u; nx = cnt > 0u ? cnt : 1u;
}
DI void xcd_barrier(const XcdBarrier& b) {
    asm volatile("s_waitcnt vmcnt(0)" ::: "memory");
    __syncthreads();
    if (b.wid == 0 && lane_now() == 0) {
        unsigned* bar = b.bar;
        __builtin_amdgcn_s_waitcnt(0);
        unsigned nloc = b.st[0], nx = b.st[1];
        if (nloc == 0u) { xcd_barrier_complete(bar, b.x, nloc, nx); b.st[0] = nloc; b.st[1] = nx; }
        const unsigned old = xb_add(&bar[XB_XSUB(b.x)], 1u);
        const unsigned gen = old / nloc;
        if (old + 1u == (gen + 1u) * nloc) {
            __builtin_amdgcn_fence(__ATOMIC_RELEASE, "agent");
            asm volatile("s_waitcnt vmcnt(0)" ::: "memory");
            const unsigned og = xb_add(&bar[XB_TOP], 1u);
            const unsigned tg = og / nx;
            if (og + 1u == (tg + 1u) * nx) xb_add(&bar[XB_TOPGEN], 1u);
            else XB_SPIN(xb_ld(&bar[XB_TOPGEN]) == tg, bar);
            __builtin_amdgcn_fence(__ATOMIC_ACQUIRE, "agent");
            xb_add(&bar[XB_XGEN(b.x)], 1u);
            asm volatile("s_waitcnt vmcnt(0)" ::: "memory");
        } else {
            XB_SPIN(xb_ld(&bar[XB_XGEN(b.x)]) == gen, bar);
            __builtin_amdgcn_fence(__ATOMIC_ACQUIRE, "agent");
            asm volatile("s_waitcnt vmcnt(0)" ::: "memory");
        }
    }
    __syncthreads();
}

__global__ void __launch_bounds__(512, 2) fwd_megakernel(Params p) {
    extern __shared__ __attribute__((aligned(16))) unsigned char lds_raw[];
    cg::grid_group grid = cg::this_grid();
    LAS unsigned char* lds = (LAS unsigned char*)lds_raw;
    const int tid = threadIdx.x, lane = tid & 63, wid = __builtin_amdgcn_readfirstlane(tid >> 6);
    const int G = gridDim.x, bx = blockIdx.x;
    const int gw = bx * 8 + wid, NGW = G * 8;
    const int vbx = ((G & 7) == 0) ? (bx & 7) * (G >> 3) + (bx >> 3) : bx;
    unsigned char* ws = p.ws;
    float* modp = (float*)(ws + WS_MODP); float* modv = (float*)(ws + WS_MODV);
    float* cosC = (float*)(ws + WS_ROPEC); float* sinC = cosC + 8192 * 32; float* cosB = (float*)(ws + WS_ROPEB); float* sinB = cosB + 8192 * 16;
    float* stA = (float*)(ws + WS_STA); float* stB = (float*)(ws + WS_STB);
    bf16_t* XN = (bf16_t*)(ws + WS_XN); bf16_t* PROJ = (bf16_t*)(ws + WS_PROJ); bf16_t* ACT = PROJ;
    bf16_t* PART = (bf16_t*)(ws + WS_PART); float* ML = (float*)(ws + WS_ML); bf16_t* YB = (bf16_t*)(ws + WS_YB);
    LAS unsigned char* wl = lds + wid * 16384;
    LAS float* wscr = (LAS float*)(lds + LDS_SCR + wid * 2560);
    volatile LAS unsigned* bst = (volatile LAS unsigned*)(lds + LDS_SCR + 8 * 2560);
    if (tid < 2) bst[tid] = 0u;
    __syncthreads();
    XcdBarrier xbar = xcd_barrier_post((unsigned*)ws, bst, wid);
#define GSYNC() xcd_barrier(xbar)

#ifndef NO_P0
    {
        LAS float* scr = (LAS float*)wl;
        constexpr int I_IN = 16 * 96, I_OUT = 16 * 32, I_GU = 16 * 176, I_DN = 44 * 32, I_L = I_IN + I_OUT + I_GU + I_DN;
        for (int it = gw; it < 2 * I_L; it += NGW) {
            const int l = it / I_L; int r = it % I_L; bf16_t* wb = (bf16_t*)(ws + WS_W + (size_t)l * W_LAYER);
            if (r < I_IN) { transpose_item(p.w_in + (size_t)l * DM * NQKV, DM, NQKV, (bf16_t*)((unsigned char*)wb + W_IN), 0, scr, r, lane); continue; } r -= I_IN;
            if (r < I_OUT) { transpose_item(p.w_out + (size_t)l * DM * DM, DM, DM, (bf16_t*)((unsigned char*)wb + W_OUT), 1, scr, r, lane); continue; } r -= I_OUT;
            if (r < I_GU) { transpose_item(p.w_gu + (size_t)l * DM * NGU, DM, NGU, (bf16_t*)((unsigned char*)wb + W_GU), 2, scr, r, lane); continue; } r -= I_GU;
            transpose_item(p.w_down + (size_t)l * FF * DM, FF, DM, (bf16_t*)((unsigned char*)wb + W_DOWN), 1, scr, r, lane);
        }
        for (int e = bx * 512 + tid; e < 8192 * 48; e += G * 512) {
            float sv, cv;
            if (e < 8192 * 32) { const int pos = e >> 5, i = e & 31; const float ang = (float)pos * p.invfC[i]; sincos_d(ang, sv, cv); cosC[e] = cv; sinC[e] = sv; }
            else { const int e2 = e - 8192 * 32; const int pos = e2 >> 4, i = e2 & 15; const float ang = (float)pos * p.invfB[i]; sincos_d(ang, sv, cv); cosB[e2] = cv; sinB[e2] = sv; }
        }
        __syncthreads();
        LAS float* sl = (LAS float*)lds;
        for (int it = bx; it < 2 * 12 * 8; it += G) {
            const int ks = it & 7, cb = (it >> 3) % 12, l = it / 96;
            for (int idx = tid; idx < NSEQ * 128; idx += 512) { const int s = idx >> 7, kk = idx & 127;
                const float cvv = (s < 8) ? p.c[0][s * DM + ks * 128 + kk] : p.c[1][(s - 8) * DM + ks * 128 + kk];
                sl[idx] = cvv / (1.0f + __expf(-cvv)); }
            __syncthreads();
            float acc[NSEQ];
#pragma unroll
            for (int s = 0; s < NSEQ; ++s) acc[s] = 0.f;
            const float* wp = p.w_ada + ((size_t)l * DM + ks * 128) * 6144 + cb * 512 + tid;
            for (int kk = 0; kk < 128; kk += 4) {
                const float w0 = wp[(size_t)kk * 6144], w1 = wp[(size_t)(kk + 1) * 6144], w2 = wp[(size_t)(kk + 2) * 6144], w3 = wp[(size_t)(kk + 3) * 6144];
#pragma unroll
                for (int s = 0; s < NSEQ; ++s) { const f32x4 sv = *(LAS const f32x4*)(sl + s * 128 + kk); acc[s] += (sv.x * w0 + sv.y * w1) + (sv.z * w2 + sv.w * w3); }
            }
#pragma unroll
            for (int s = 0; s < NSEQ; ++s) modp[(((size_t)ks * 2 + l) * NSEQ + s) * 6144 + cb * 512 + tid] = acc[s];
            __syncthreads();
        }
    }
#endif
    grid.sync();
    for (int e = bx * 512 + tid; e < 2 * NSEQ * 6144; e += G * 512) {
        const int jcol = e % 6144, l = e / (NSEQ * 6144);
        float v = p.b_ada[l * 6144 + jcol];
#pragma unroll
        for (int ks = 0; ks < 8; ++ks) v += modp[(size_t)ks * 2 * NSEQ * 6144 + e];
        modv[e] = v;
    }
    GSYNC();

    pg8::StaticOrder SO;
    for (int hf = 0; hf < 2; ++hf) {
        const int S = hf ? 2048 : 8192, Sshift = hf ? 11 : 13, seq0 = hf ? 8 : 0, nseq = hf ? 32 : 8;
        const float* xin = p.x[hf]; float* outh = p.out + (size_t)hf * TH * DM;
        for (int l = 0; l < 2; ++l) {
            const unsigned char* wb = ws + WS_W + (size_t)l * W_LAYER;
            const bf16_t* Win_t = (const bf16_t*)(wb + W_IN); const bf16_t* Wout_t = (const bf16_t*)(wb + W_OUT);
            const bf16_t* Wgu_t = (const bf16_t*)(wb + W_GU); const bf16_t* Wdn_t = (const bf16_t*)(wb + W_DOWN);
            const float* modbase = modv + ((size_t)l * NSEQ + seq0) * 6144;
            if (l == 0) ln_pass<false, false>(xin, XN, stA, nullptr, nullptr, modbase, 0, Sshift, gw, lane_now());
            else ln_pass<true, true>(YB, XN, stA, p.ln2_g + (l - 1) * DM, p.ln2_b + (l - 1) * DM, modbase, 0, Sshift, gw, lane_now());
            GSYNC();
#ifndef NO_QKV
            { pg8::Gemm g{XN, Win_t, TH, NQKV, DM}; SO.init(TH, NQKV, G, bx);
              pg8::EpiQKV E{PROJ, cosC, sinC, cosB, sinB, S - 1, lds + LDS_SCR};
              pg8::gemm_phase<pg8::EpiQKV>(lds, g, SO, E, wid); }
#endif
            GSYNC();
            {
#ifndef NO_A
                for (int rep = 0; rep < REP_AC; ++rep) walk_na(Sshift, nseq, l, PROJ, XN, p.na_rpb, lds, wscr, wid, lane_now(), vbx * 2 + (wid >> 2));
#endif
#ifndef NO_C
                for (int rep = 0; rep < REP_AC; ++rep) {
                    walk_dil<0>(Sshift, nseq, 2, 0, PROJ, XN, PART, ML, lds, wid, lane_now(), vbx * 2 + (wid >> 2));
                    walk_dil<0>(Sshift, nseq, 4, 1, PROJ, XN, PART, ML, lds, wid, lane_now(), vbx * 2 + (wid >> 2)); }
#endif
                __syncthreads();
#ifndef NO_B
                float d01 = 0.f, d23 = 0.f; const float* lf = p.diff_lambda + l * 128;
                for (int i = 0; i < 32; ++i) { d01 += lf[i] * lf[32 + i]; d23 += lf[64 + i] * lf[96 + i]; }
                const float lam = __expf(d01) - __expf(d23) + p.lambda_init[l]; const float post = 1.0f - p.lambda_init[l];
                const int nB = nseq * 4 * (S >> 8);
                for (int rep = 0; rep < REP_B; ++rep)
                for (int u = vbx; u < nB; u += G) attn_diff_unit(u, Sshift, lam, post, p.diff_subln_g + l * 64, PROJ, XN, lds, wid, lane_now());
#endif
            }
            GSYNC();
            {
#ifndef NO_C1
              for (int rep = 0; rep < REP_AC; ++rep) walk_dil<1>(Sshift, nseq, 0, 0, PROJ, XN, PART, ML, lds, wid, lane_now(), vbx * 2 + (wid >> 2));
#endif
              __syncthreads(); }
            GSYNC();
#ifndef NO_RES
            { pg8::Gemm g{XN, Wout_t, TH, DM, DM}; SO.init(TH, DM, G, bx);
              if (l == 0) { pg8::EpiRes<false, true> E{xin, YB, nullptr, p.ln2_g, p.ln2_b, modbase + 2 * 1024, Sshift};
                  pg8::gemm_phase<pg8::EpiRes<false, true>>(lds, g, SO, E, wid); }
              else { pg8::EpiRes<true, true> E{YB, YB, stA, p.ln2_g + (l - 1) * DM, p.ln2_b + (l - 1) * DM, modbase + 2 * 1024, Sshift};
                  pg8::gemm_phase<pg8::EpiRes<true, true>>(lds, g, SO, E, wid); } }
#endif
            GSYNC();
            ln_pass<true, true>(YB, XN, stB, p.ln1_g + l * DM, p.ln1_b + l * DM, modbase, 3, Sshift, gw, lane_now());
            GSYNC();
#ifndef NO_GU
            { pg8::Gemm g{XN, Wgu_t, TH, NGU, DM}; SO.init(TH, NGU, G, bx);
              pg8::EpiSwiGLU E{ACT};
              pg8::gemm_phase<pg8::EpiSwiGLU>(lds, g, SO, E, wid); }
#endif
            GSYNC();
#ifndef NO_RES
            { pg8::Gemm g{ACT, Wdn_t, TH, DM, FF}; SO.init(TH, DM, G, bx);
              if (l == 0) { pg8::EpiRes<true, true> E{YB, YB, stB, p.ln1_g + l * DM, p.ln1_b + l * DM, modbase + 5 * 1024, Sshift};
                  pg8::gemm_phase<pg8::EpiRes<true, true>>(lds, g, SO, E, wid); }
              else { pg8::EpiRes<true, false> E{YB, outh, stB, p.ln1_g + l * DM, p.ln1_b + l * DM, modbase + 5 * 1024, Sshift};
                  pg8::gemm_phase<pg8::EpiRes<true, false>>(lds, g, SO, E, wid); } }
#endif
            GSYNC();
        }
        final_ln(outh, p.ln2_g + DM, p.ln2_b + DM, gw, lane_now());
    }
}

extern "C" void kernel_launch(void* const* d_in, const int* in_sizes, int n_in, void* d_out, int out_size, void* d_ws, size_t ws_size, hipStream_t stream) {
    static int grid = 0;
    if (grid == 0) {
        if (n_in != 17 || ws_size < WS_END) { fprintf(stderr, "kernel_launch: unexpected inputs (%d) or workspace (%zu < %zu)\n", n_in, ws_size, (size_t)WS_END); grid = -1; return; }
        int dev = 0, cus = 0, per_cu = 0;
        hipGetDevice(&dev); hipDeviceGetAttribute(&cus, hipDeviceAttributeMultiprocessorCount, dev);
        hipFuncSetAttribute((const void*)fwd_megakernel, hipFuncAttributeMaxDynamicSharedMemorySize, LDS_BYTES);
        hipOccupancyMaxActiveBlocksPerMultiprocessor(&per_cu, (const void*)fwd_megakernel, 512, LDS_BYTES);
        if (per_cu < 1) { fprintf(stderr, "kernel_launch: occupancy query says %d blocks per CU\n", per_cu); per_cu = 1; }
        (void)hipGetLastError();
        if (cus != 256) { fprintf(stderr, "kernel_launch: built for a 256-CU device (got %d)\n", cus); grid = -1; return; }
        grid = 256;
    }
    if (grid < 0) return;
    Params p{};
    p.x[0] = (const float*)d_in[0]; p.x[1] = (const float*)d_in[1]; p.c[0] = (const float*)d_in[2]; p.c[1] = (const float*)d_in[3];
    p.w_ada = (const float*)d_in[4]; p.b_ada = (const float*)d_in[5]; p.w_in = (const float*)d_in[6]; p.na_rpb = (const float*)d_in[7];
    p.diff_lambda = (const float*)d_in[8]; p.diff_subln_g = (const float*)d_in[9]; p.w_out = (const float*)d_in[10];
    p.ln1_g = (const float*)d_in[11]; p.ln1_b = (const float*)d_in[12]; p.w_gu = (const float*)d_in[13]; p.w_down = (const float*)d_in[14];
    p.ln2_g = (const float*)d_in[15]; p.ln2_b = (const float*)d_in[16];
    p.out = (float*)d_out; p.ws = (unsigned char*)d_ws;
    for (int i = 0; i < 32; ++i) p.invfC[i] = powf(10000.0f, -(float)i / 32.0f);
    for (int i = 0; i < 16; ++i) p.invfB[i] = powf(10000.0f, -(float)i / 16.0f);
    for (int l = 0; l < 2; ++l) p.lambda_init[l] = (float)(0.8 - 0.6 * exp(-0.3 * (double)l));
    if (hipMemsetAsync(d_ws, 0, 16384, stream) != hipSuccess) { fprintf(stderr, "kernel_launch: memset of the barrier words failed\n"); return; }
    void* args[] = {&p};
    hipError_t e = hipLaunchCooperativeKernel((const void*)fwd_megakernel, dim3(grid), dim3(512), args, LDS_BYTES, stream);
    if (e != hipSuccess) fprintf(stderr, "cooperative launch failed: %s (grid %d)\n", hipGetErrorString(e), grid);
}
```
